# Optimizing an MI355X kernel written in HIP

```python
import numpy as np
import jax
import jax.numpy as jnp
from jax import lax

D_MODEL = 1024
BATCH = 1
SEQ = 16384
DEPTH = 4

HEAD_DIM = 64
N_MIXERS = 2
A_Q_HEADS = 16
A_KV_HEADS = 4
A_HALF_WINDOW = 128
B_GROUPS = ((128, 1), (512, 4), (2048, 16))
B_Q_HEADS = 8
B_KV_HEADS = 2
D_FF = -(-8 * D_MODEL // (3 * 256)) * 256
A_QKV = (A_Q_HEADS + 2 * A_KV_HEADS) * HEAD_DIM
B_QKV = len(B_GROUPS) * (B_Q_HEADS + 2 * B_KV_HEADS) * HEAD_DIM
A_OUT = A_Q_HEADS * HEAD_DIM
B_OUT = B_Q_HEADS * HEAD_DIM
N_A_LAYERS = (DEPTH + 1) // 2
N_B_LAYERS = DEPTH // 2
RMS_EPS = 1e-6
NEG = -1e30

kernel_name = "hybrid_window_dilated_alibi_encoder"


def rmsnorm(x, g):
    xf = x.astype(jnp.float32)
    y = xf * lax.rsqrt(jnp.mean(xf * xf, axis=-1, keepdims=True) + RMS_EPS)
    return (y * g.astype(jnp.float32)).astype(x.dtype)


def alibi_slopes(n):
    return jnp.asarray(2.0 ** (-8.0 * np.arange(1, n + 1) / n), dtype=jnp.float32)


def banded_attention(q, k, v, half_window, slopes, dist_scale, sink=None):
    n, L, hkv, g, dh = q.shape
    blk = half_window
    nb = -(-L // blk)
    lp = nb * blk
    qb = jnp.pad(q, ((0, 0), (0, lp - L), (0, 0), (0, 0), (0, 0))).reshape(n, nb, blk, hkv, g, dh)
    pad_kv = ((0, 0), (blk, lp - L + blk), (0, 0), (0, 0))
    kb = jnp.pad(k, pad_kv).reshape(n, nb + 2, blk, hkv, dh)
    vb = jnp.pad(v, pad_kv).reshape(n, nb + 2, blk, hkv, dh)
    kw = jnp.concatenate([kb[:, :-2], kb[:, 1:-1], kb[:, 2:]], axis=2)
    vw = jnp.concatenate([vb[:, :-2], vb[:, 1:-1], vb[:, 2:]], axis=2)
    rel = jnp.arange(3 * blk)[None, :] - blk - jnp.arange(blk)[:, None]
    kpos = jnp.arange(nb)[:, None] * blk - blk + jnp.arange(3 * blk)[None, :]
    mask = (jnp.abs(rel) <= half_window)[None] & ((kpos >= 0) & (kpos < L))[:, None, :]
    dist = (dist_scale * jnp.abs(rel)).astype(jnp.float32)
    bias = -slopes.astype(jnp.float32)[:, :, None, None] * dist
    s = jnp.einsum('nbqhgd,nbkhd->nbhgqk', qb, kw,
                   preferred_element_type=jnp.float32) * (dh ** -0.5) + bias
    s = jnp.where(mask[None, :, None, None], s, NEG)
    m = s.max(axis=-1)
    if sink is not None:
        sk = sink.astype(jnp.float32)[:, :, None]
        m = jnp.maximum(m, sk)
    p = jnp.exp(s - m[..., None])
    l = p.sum(axis=-1)
    if sink is not None:
        l = l + jnp.exp(sk - m)
    o = jnp.einsum('nbhgqk,nbkhd->nbqhgd', p, vw.astype(jnp.float32))
    o = o / jnp.moveaxis(l, -1, 2)[..., None]
    lse = jnp.moveaxis(m + jnp.log(l), -1, 2)
    o = o.reshape(n, lp, hkv, g, dh)[:, :L].astype(q.dtype)
    lse = lse.reshape(n, lp, hkv, g)[:, :L]
    return o, lse


def to_strided(t, dil):
    b, s = t.shape[:2]
    rest = t.shape[2:]
    t = t.reshape(b, s // dil, dil, *rest)
    return jnp.moveaxis(t, 2, 1).reshape(b * dil, s // dil, *rest)


def from_strided(t, b, dil):
    l = t.shape[1]
    rest = t.shape[2:]
    t = t.reshape(b, dil, l, *rest)
    return jnp.moveaxis(t, 1, 2).reshape(b, l * dil, *rest)


def windowed_gqa(h, w_in, w_out, sink):
    b, s, _ = h.shape
    gq = A_Q_HEADS // A_KV_HEADS
    dq, dk = A_Q_HEADS * HEAD_DIM, A_KV_HEADS * HEAD_DIM
    qkv = h @ w_in
    q = qkv[..., :dq].reshape(b, s, A_KV_HEADS, gq, HEAD_DIM)
    k = qkv[..., dq:dq + dk].reshape(b, s, A_KV_HEADS, HEAD_DIM)
    v = qkv[..., dq + dk:].reshape(b, s, A_KV_HEADS, HEAD_DIM)
    slopes = alibi_slopes(A_Q_HEADS).reshape(A_KV_HEADS, gq)
    o, _ = banded_attention(q, k, v, A_HALF_WINDOW, slopes, 1, sink.reshape(A_KV_HEADS, gq))
    return o.reshape(b, s, A_OUT) @ w_out


def dilated_attention(h, w_in, w_out):
    b, s, _ = h.shape
    ng = len(B_GROUPS)
    gq = B_Q_HEADS // B_KV_HEADS
    dq, dk = ng * B_Q_HEADS * HEAD_DIM, ng * B_KV_HEADS * HEAD_DIM
    qkv = h @ w_in
    q = qkv[..., :dq].reshape(b, s, ng, B_KV_HEADS, gq, HEAD_DIM)
    k = qkv[..., dq:dq + dk].reshape(b, s, ng, B_KV_HEADS, HEAD_DIM)
    v = qkv[..., dq + dk:].reshape(b, s, ng, B_KV_HEADS, HEAD_DIM)
    slopes = alibi_slopes(ng * B_Q_HEADS).reshape(ng, B_KV_HEADS, gq)
    outs, lses = [], []
    for gi, (window, dil) in enumerate(B_GROUPS):
        half = window // (2 * dil)
        o, lse = banded_attention(to_strided(q[:, :, gi], dil), to_strided(k[:, :, gi], dil),
                                  to_strided(v[:, :, gi], dil), half, slopes[gi], dil)
        outs.append(from_strided(o, b, dil))
        lses.append(from_strided(lse, b, dil))
    alpha = jax.nn.softmax(jnp.stack(lses), axis=0)
    o = jnp.einsum('nbshg,nbshgd->bshgd', alpha,
                   jnp.stack(outs).astype(jnp.float32)).astype(h.dtype)
    return o.reshape(b, s, B_OUT) @ w_out


def swiglu(h, w_in, w_out):
    gu = h @ w_in
    gate, up = jnp.split(gu, 2, axis=-1)
    return (jax.nn.silu(gate) * up) @ w_out


def setup_inputs(seed: int = 0) -> dict:
    key = jax.random.key(seed)
    ks = jax.random.split(key, 16)
    D = D_MODEL
    nrm = lambda k, shape, scale: jax.random.normal(k, shape, jnp.float32) * scale
    return {
        "x": nrm(ks[0], (BATCH, SEQ, D), 1.0),
        "c": nrm(ks[1], (BATCH, D), 1.0),
        "ada_w": nrm(ks[2], (DEPTH, D, 6 * D), 0.5 * D ** -0.5),
        "ada_b": nrm(ks[3], (DEPTH, 6 * D), 0.1),
        "norm_mix": 1.0 + nrm(ks[4], (DEPTH, D), 0.05),
        "norm_ffn": 1.0 + nrm(ks[5], (DEPTH, D), 0.05),
        "ffn_w_in": nrm(ks[6], (DEPTH, D, 2 * D_FF), D ** -0.5),
        "ffn_w_out": nrm(ks[7], (DEPTH, D_FF, D), D_FF ** -0.5),
        "a_w_in": nrm(ks[8], (N_A_LAYERS, D, A_QKV), D ** -0.5),
        "a_w_out": nrm(ks[9], (N_A_LAYERS, A_OUT, D), A_OUT ** -0.5),
        "a_sink": nrm(ks[10], (N_A_LAYERS, A_Q_HEADS), 0.5),
        "b_w_in": nrm(ks[11], (N_B_LAYERS, D, B_QKV), D ** -0.5),
        "b_w_out": nrm(ks[12], (N_B_LAYERS, B_OUT, D), B_OUT ** -0.5),
        "final_norm": 1.0 + nrm(ks[13], (D,), 0.05),
    }


def reference(x, c, ada_w, ada_b, norm_mix, norm_ffn, ffn_w_in, ffn_w_out,
              a_w_in, a_w_out, a_sink, b_w_in, b_w_out, final_norm):
    cond = jax.nn.silu(c)
    for i in range(DEPTH):
        mod = (cond @ ada_w[i] + ada_b[i])[:, None, :]
        sh1, sc1, g1, sh2, sc2, g2 = jnp.split(mod, 6, axis=-1)
        h = rmsnorm(x, norm_mix[i]) * (1 + sc1) + sh1
        j = i // N_MIXERS
        if i % N_MIXERS == 0:
            y = windowed_gqa(h, a_w_in[j], a_w_out[j], a_sink[j])
        else:
            y = dilated_attention(h, b_w_in[j], b_w_out[j])
        x = x + g1 * y
        h = rmsnorm(x, norm_ffn[i]) * (1 + sc2) + sh2
        x = x + g2 * swiglu(h, ffn_w_in[i], ffn_w_out[i])
    return rmsnorm(x, final_norm)
```

```cpp
#include <hip/hip_runtime.h>
#include <cstdio>
#include <cstdint>
namespace pg8 {
#define PG8_LAS __attribute__((address_space(3)))
typedef unsigned short bf16_t;
typedef short bf16x8 __attribute__((ext_vector_type(8)));
typedef float f32x4 __attribute__((ext_vector_type(4)));
typedef unsigned u32x4 __attribute__((ext_vector_type(4)));
constexpr int BM = 256, BK = 64, HALF = 128, HTB = HALF * BK * 2  , STAGE_BYTES = 8 * HTB, NXCD = 8, WGM = 8;

__host__ __device__ __forceinline__ int lds_byte(int r, int c) { const int st = (r >> 4) * 2 + (c >> 5), rr = r & 15, cc = c & 31, ob = rr * 64 + cc * 2; return st * 1024 + (ob ^ (((ob >> 9) & 1) << 5)); }
__host__ __device__ __forceinline__ void stage_rc(int b, int& R, int& C) { const int st = b / 1024, sb = b % 1024, swz = sb ^ (((sb >> 9) & 1) << 5); R = (st >> 1) * 16 + swz / 64; C = (st & 1) * 32 + (swz % 64) / 2; }
__host__ __device__ __forceinline__ int perm32(int rho) { const int n = rho >> 4, i = rho & 15; return 8 * (i >> 2) + 4 * n + (i & 3); }

struct Unit { int pm, pn; };
struct Gemm { const bf16_t* A; const bf16_t* Bt; int M, N, K; };

struct StaticOrder {
    int nM, nN, nwg, G, c;
    __host__ __device__ void init(int M, int N, int G_, int c_) { nM = M / BM; nN = N / BM; nwg = nM * nN; G = G_; c = c_; }
    __host__ __device__ bool next(int i, Unit& u) const {
        const long L = (long)i * G + c; if (L >= nwg) return false;
        int wgid = (int)L; { const int q = nwg / NXCD, r = nwg % NXCD, xcd = wgid % NXCD, off = wgid / NXCD; wgid = (xcd < r ? xcd * (q + 1) : r * (q + 1) + (xcd - r) * q) + off; }
        const int nig = WGM * nN, gid = wgid / nig, fm = gid * WGM, gsz = (nM - fm) < WGM ? (nM - fm) : WGM;
        u.pm = fm + ((wgid % nig) % gsz); u.pn = (wgid % nig) / gsz; return true;
    }
    __device__ __forceinline__ void a_ready(const Unit&) const {}
    __device__ __forceinline__ void done(const Unit&) const {}
};

__device__ __forceinline__ unsigned cvt_pk_bf16(float lo, float hi) { unsigned r; asm volatile("v_cvt_pk_bf16_f32 %0, %1, %2" : "=v"(r) : "v"(lo), "v"(hi)); return r; }
constexpr int MROWS = 16384;
constexpr float RMS_EPS_F = 1e-6f;
__device__ __forceinline__ float row_rstd(const float* ssq, int row) {
    const float s = (ssq[row] + ssq[MROWS + row]) + (ssq[2 * MROWS + row] + ssq[3 * MROWS + row]);
    return __builtin_amdgcn_rsqf(s * (1.0f / 1024.0f) + RMS_EPS_F);
}
struct EpiQKV {
    static constexpr bool PERM = true, AFTER_DRAIN = false;
    bf16_t* O; int ldc; const float* bias; const float* ssq;
    __device__ __forceinline__ void operator()(const f32x4 (&acc)[2][2][4][2], const Unit& u, int wr, int wc, int fr, int fq) const {
        const int row0 = u.pm * BM + wr * 64 + fr; const int col0 = u.pn * BM + wc * 32 + 8 * fq;
        f32x4 bv[2][2];
#pragma unroll
        for (int bj = 0; bj < 2; ++bj)
#pragma unroll
            for (int n = 0; n < 2; ++n) bv[bj][n] = *(const f32x4*)(bias + col0 + bj * HALF + 4 * n);
#pragma unroll
        for (int ai = 0; ai < 2; ++ai)
#pragma unroll
            for (int m = 0; m < 4; ++m) { const int row = row0 + ai * HALF + m * 16; const float rs = row_rstd(ssq, row); bf16_t* rowp = O + (size_t)row * ldc + col0;
#pragma unroll
                for (int bj = 0; bj < 2; ++bj) { const f32x4 v0 = acc[ai][bj][m][0] * rs + bv[bj][0], v1 = acc[ai][bj][m][1] * rs + bv[bj][1];
                    u32x4 w; w.x = cvt_pk_bf16(v0[0], v0[1]); w.y = cvt_pk_bf16(v0[2], v0[3]); w.z = cvt_pk_bf16(v1[0], v1[1]); w.w = cvt_pk_bf16(v1[2], v1[3]);
                    *(u32x4*)(rowp + bj * HALF) = w; } }
    }
};
__device__ __forceinline__ float silu_mul(float g, float up) { const float e = __builtin_amdgcn_exp2f(g * -1.4426950408889634f); return g * up * __builtin_amdgcn_rcpf(1.0f + e); }
struct EpiSwiGLU {
    static constexpr bool PERM = true, AFTER_DRAIN = false;
    bf16_t* O; int ldo; const float* bias; const float* ssq;
    __device__ __forceinline__ void operator()(const f32x4 (&acc)[2][2][4][2], const Unit& u, int wr, int wc, int fr, int fq) const {
        const int row0 = u.pm * BM + wr * 64 + fr; const int col0 = u.pn * BM + wc * 32 + 8 * fq; const int ocol = u.pn * HALF + wc * 32 + 8 * fq;
        f32x4 bv[2][2];
#pragma unroll
        for (int bj = 0; bj < 2; ++bj)
#pragma unroll
            for (int n = 0; n < 2; ++n) bv[bj][n] = *(const f32x4*)(bias + col0 + bj * HALF + 4 * n);
#pragma unroll
        for (int ai = 0; ai < 2; ++ai)
#pragma unroll
            for (int m = 0; m < 4; ++m) { const int row = row0 + ai * HALF + m * 16; const float rs = row_rstd(ssq, row);
                const f32x4 g0 = acc[ai][0][m][0] * rs + bv[0][0], g1 = acc[ai][0][m][1] * rs + bv[0][1], u0 = acc[ai][1][m][0] * rs + bv[1][0], u1 = acc[ai][1][m][1] * rs + bv[1][1];
                u32x4 w; w.x = cvt_pk_bf16(silu_mul(g0[0], u0[0]), silu_mul(g0[1], u0[1])); w.y = cvt_pk_bf16(silu_mul(g0[2], u0[2]), silu_mul(g0[3], u0[3]));
                w.z = cvt_pk_bf16(silu_mul(g1[0], u1[0]), silu_mul(g1[1], u1[1])); w.w = cvt_pk_bf16(silu_mul(g1[2], u1[2]), silu_mul(g1[3], u1[3]));
                *(u32x4*)(O + (size_t)row * ldo + ocol) = w; }
    }
};
struct EpiResid {
    static constexpr bool PERM = true, AFTER_DRAIN = true;
    const float* xin; float* xout; bf16_t* xb; float* ssq_out;
    __device__ __forceinline__ void fused(f32x4 (&acc)[2][2][4][2], const Unit& u, int wr, int wc, int fr, int fq, PG8_LAS unsigned char* lds, int wid, int lane) const {
        PG8_LAS float* P = (PG8_LAS float*)lds;
        const int col0 = u.pn * BM + wc * 32 + 8 * fq;
#pragma unroll
        for (int ai = 0; ai < 2; ++ai)
#pragma unroll
            for (int m = 0; m < 4; ++m) { const int rl = ai * HALF + wr * 64 + m * 16 + fr; const size_t off = (size_t)(u.pm * BM + rl) * 1024 + col0; float s = 0.f;
#pragma unroll
                for (int bj = 0; bj < 2; ++bj) {
                    const f32x4 x0 = *(const f32x4*)(xin + off + bj * HALF), x1 = *(const f32x4*)(xin + off + bj * HALF + 4);
                    const f32x4 v0 = x0 + acc[ai][bj][m][0], v1 = x1 + acc[ai][bj][m][1];
                    *(f32x4*)(xout + off + bj * HALF) = v0; *(f32x4*)(xout + off + bj * HALF + 4) = v1;
                    s += (v0[0] * v0[0] + v0[1] * v0[1]) + (v0[2] * v0[2] + v0[3] * v0[3]) + (v1[0] * v1[0] + v1[1] * v1[1]) + (v1[2] * v1[2] + v1[3] * v1[3]);
                    u32x4 w; w.x = cvt_pk_bf16(v0[0], v0[1]); w.y = cvt_pk_bf16(v0[2], v0[3]); w.z = cvt_pk_bf16(v1[0], v1[1]); w.w = cvt_pk_bf16(v1[2], v1[3]);
                    *(u32x4*)(xb + off + bj * HALF) = w; }
                s += __shfl_xor(s, 16); s += __shfl_xor(s, 32);
                if (fq == 0) P[rl * 4 + wc] = s;
                if (m & 1) asm volatile("" ::: "memory"); }
        asm volatile("s_waitcnt lgkmcnt(0)" ::: "memory"); __builtin_amdgcn_s_barrier(); asm volatile("" ::: "memory");
        if (lane < 32) { const int row = wid * 32 + lane; const float t = (P[row * 4 + 0] + P[row * 4 + 1]) + (P[row * 4 + 2] + P[row * 4 + 3]);
            ssq_out[(size_t)u.pn * MROWS + u.pm * BM + row] = t; }
        asm volatile("s_waitcnt lgkmcnt(0)" ::: "memory"); __builtin_amdgcn_s_barrier(); asm volatile("" ::: "memory");
    }
};

template <class Epi, class Sched, bool ALIGN_EPI = false, bool SP2 = false>
__device__ __forceinline__ void gemm_phase(PG8_LAS unsigned char* lds, const Gemm g, const Sched& S, const Epi& E) {
    int tid_ = threadIdx.x; asm volatile("" : "+v"(tid_));
    const int tid = tid_, wid = __builtin_amdgcn_readfirstlane(tid >> 6), lane = tid & 63, wr = wid >> 2, wc = wid & 3, fr = lane & 15, fq = lane >> 4;
    const int K = g.K, nt = K / BK;
    unsigned voffA[2], voffB[2];
#pragma unroll
    for (int i = 0; i < 2; ++i) { int R, C; stage_rc(tid * 16 + i * 8192, R, C); const int Rb = Epi::PERM ? ((R & ~31) + perm32(R & 31)) : R;
        voffA[i] = (unsigned)(R * K + C) * 2u; voffB[i] = (unsigned)(Rb * K + C) * 2u; }
    const size_t kstep = (size_t)(BK * 2);
    const size_t hstep = (size_t)HALF * K * 2;
    const size_t tstep = 2 * hstep;
    const unsigned ldsw = (unsigned)wid * 1024u;
    const int aoff = lds_byte(wr * 64 + fr, fq * 8), boff = lds_byte(wc * 32 + fr, fq * 8);
#define PG8_SA(b, h) (((b) * 2 + (h)) * HTB)
#define PG8_SB(b, h) ((4 + (b) * 2 + (h)) * HTB)
#define PG8_STAGE(bufoff, gbase, voff) do { _Pragma("unroll") for (int _i = 0; _i < 2; ++_i) \
        __builtin_amdgcn_global_load_lds((const unsigned*)((const char*)(gbase) + (voff)[_i]), (PG8_LAS unsigned*)(lds + (bufoff) + ldsw + _i * 8192), 16, 0, 0); } while (0)
#define PG8_LDA(dst, b, h) do { _Pragma("unroll") for (int m = 0; m < 4; ++m) _Pragma("unroll") for (int k = 0; k < 2; ++k) dst[m][k] = *(const PG8_LAS bf16x8*)(lds + PG8_SA(b, h) + aoff + m * 2048 + k * 1024); } while (0)
#define PG8_LDB(dst, b, h) do { _Pragma("unroll") for (int n = 0; n < 2; ++n) _Pragma("unroll") for (int k = 0; k < 2; ++k) dst[n][k] = *(const PG8_LAS bf16x8*)(lds + PG8_SB(b, h) + boff + n * 2048 + k * 1024); } while (0)
#define PG8_MMA(ai, bj, At, Bt) do { __builtin_amdgcn_s_setprio(1); _Pragma("unroll") for (int m = 0; m < 4; ++m) _Pragma("unroll") for (int n = 0; n < 2; ++n) _Pragma("unroll") for (int k = 0; k < 2; ++k) \
        acc[ai][bj][m][n] = __builtin_amdgcn_mfma_f32_16x16x32_bf16(Bt[n][k], At[m][k], acc[ai][bj][m][n], 0, 0, 0); __builtin_amdgcn_s_setprio(0); } while (0)
#define PG8_WAIT_V(n) asm volatile("s_waitcnt vmcnt(" #n ")" ::: "memory")
#define PG8_WAIT_L(n) asm volatile("s_waitcnt lgkmcnt(" #n ")" ::: "memory")
#define PG8_BAR __builtin_amdgcn_s_barrier()
#define PG8_SCHED __builtin_amdgcn_sched_barrier(0)
    Unit cur, nxt; int ui = 0;
    if (!S.next(0, cur)) return;
    f32x4 acc[2][2][4][2];
#pragma unroll
    for (int a = 0; a < 2; ++a)
#pragma unroll
        for (int b = 0; b < 2; ++b)
#pragma unroll
            for (int m = 0; m < 4; ++m)
#pragma unroll
                for (int n = 0; n < 2; ++n) acc[a][b][m][n] = (f32x4){0.f, 0.f, 0.f, 0.f};
    bf16x8 At[4][2], B0[2][2], B1[2][2];
    const char* cA = (const char*)g.A + (size_t)cur.pm * tstep; const char* cB = (const char*)g.Bt + (size_t)cur.pn * tstep;
    S.a_ready(cur);
    if constexpr (SP2) {
        PG8_STAGE(PG8_SB(0, 0), cB, voffB); PG8_STAGE(PG8_SB(0, 1), cB + hstep, voffB); PG8_STAGE(PG8_SA(0, 0), cA, voffA); PG8_STAGE(PG8_SA(0, 1), cA + hstep, voffA);
        if (wr == 1) PG8_BAR;
        PG8_WAIT_V(2); PG8_BAR;
        PG8_STAGE(PG8_SB(1, 0), cB + kstep, voffB); PG8_STAGE(PG8_SA(1, 0), cA + kstep, voffA); PG8_STAGE(PG8_SB(1, 1), cB + hstep + kstep, voffB);
        PG8_WAIT_V(6); PG8_BAR;
    } else {
        PG8_STAGE(PG8_SB(0, 0), cB, voffB); PG8_STAGE(PG8_SA(0, 0), cA, voffA); PG8_STAGE(PG8_SB(0, 1), cB + hstep, voffB); PG8_STAGE(PG8_SA(0, 1), cA + hstep, voffA);
        if (wr == 1) PG8_BAR;
        PG8_WAIT_V(4); PG8_BAR;
        PG8_STAGE(PG8_SB(1, 0), cB + kstep, voffB); PG8_STAGE(PG8_SA(1, 0), cA + kstep, voffA); PG8_STAGE(PG8_SB(1, 1), cB + hstep + kstep, voffB);
        PG8_WAIT_V(6); PG8_BAR;
    }
    for (;;) {
        const bool has_next = S.next(ui + 1, nxt);
        const char* nA = has_next ? (const char*)g.A + (size_t)nxt.pm * tstep : cA; const char* nB = has_next ? (const char*)g.Bt + (size_t)nxt.pn * tstep : cB;
        for (int t = 0; t < nt; t += 2) {
            const bool last = (t == nt - 2);
            const char* a1 = cA + (size_t)(t + 1) * kstep;
            const char* a2 = last ? nA : cA + (size_t)(t + 2) * kstep; const char* b2 = last ? nB : cB + (size_t)(t + 2) * kstep;
            const char* a3 = a2 + kstep; const char* b3 = b2 + kstep;
            if (last && has_next) S.a_ready(nxt);
            if constexpr (SP2) {
            PG8_LDB(B0, 0, 0); PG8_LDB(B1, 0, 1); PG8_SCHED; PG8_LDA(At, 0, 0); PG8_STAGE(PG8_SA(1, 1), a1 + hstep, voffA);
            PG8_WAIT_V(8); PG8_WAIT_L(0); PG8_BAR; PG8_MMA(0, 0, At, B0); PG8_MMA(0, 1, At, B1); PG8_BAR; PG8_SCHED;
            PG8_LDA(At, 0, 1); PG8_STAGE(PG8_SB(0, 0), b2, voffB); PG8_STAGE(PG8_SB(0, 1), b2 + hstep, voffB); PG8_STAGE(PG8_SA(0, 0), a2, voffA);
            PG8_WAIT_V(8); PG8_WAIT_L(0); PG8_BAR; PG8_MMA(1, 0, At, B0); PG8_MMA(1, 1, At, B1); PG8_BAR; PG8_SCHED;
            PG8_LDB(B0, 1, 0); PG8_LDB(B1, 1, 1); PG8_SCHED; PG8_LDA(At, 1, 0); PG8_STAGE(PG8_SA(0, 1), a2 + hstep, voffA);
            PG8_WAIT_V(8); PG8_WAIT_L(0); PG8_BAR; PG8_MMA(0, 0, At, B0); PG8_MMA(0, 1, At, B1); PG8_BAR; PG8_SCHED;
            PG8_LDA(At, 1, 1); PG8_STAGE(PG8_SB(1, 0), b3, voffB); PG8_STAGE(PG8_SB(1, 1), b3 + hstep, voffB); PG8_STAGE(PG8_SA(1, 0), a3, voffA);
            PG8_WAIT_V(8); PG8_WAIT_L(0); PG8_BAR; PG8_MMA(1, 0, At, B0); PG8_MMA(1, 1, At, B1); PG8_BAR; PG8_SCHED;
            } else {
            PG8_LDB(B0, 0, 0); PG8_SCHED; PG8_LDA(At, 0, 0); PG8_STAGE(PG8_SA(1, 1), a1 + hstep, voffA);
            PG8_WAIT_L(8); PG8_BAR; PG8_WAIT_L(0); PG8_MMA(0, 0, At, B0); PG8_BAR; PG8_SCHED;
            PG8_LDB(B1, 0, 1); PG8_STAGE(PG8_SB(0, 0), b2, voffB);
            PG8_BAR; PG8_WAIT_L(0); PG8_MMA(0, 1, At, B1); PG8_BAR;
            PG8_LDA(At, 0, 1); PG8_STAGE(PG8_SA(0, 0), a2, voffA);
            PG8_BAR; PG8_WAIT_L(0); PG8_MMA(1, 0, At, B0); PG8_BAR; PG8_SCHED;
            PG8_STAGE(PG8_SB(0, 1), b2 + hstep, voffB);
            PG8_WAIT_V(6); PG8_BAR; PG8_MMA(1, 1, At, B1); PG8_BAR;
            PG8_LDB(B0, 1, 0); PG8_SCHED; PG8_LDA(At, 1, 0); PG8_STAGE(PG8_SA(0, 1), a2 + hstep, voffA);
            PG8_WAIT_L(8); PG8_BAR; PG8_WAIT_L(0); PG8_MMA(0, 0, At, B0); PG8_BAR; PG8_SCHED;
            PG8_LDB(B1, 1, 1); PG8_STAGE(PG8_SB(1, 0), b3, voffB);
            PG8_BAR; PG8_WAIT_L(0); PG8_MMA(0, 1, At, B1); PG8_BAR;
            PG8_LDA(At, 1, 1); PG8_STAGE(PG8_SA(1, 0), a3, voffA);
            PG8_BAR; PG8_WAIT_L(0); PG8_MMA(1, 0, At, B0); PG8_BAR; PG8_SCHED;
            PG8_STAGE(PG8_SB(1, 1), b3 + hstep, voffB);
            PG8_WAIT_V(6); PG8_BAR; PG8_MMA(1, 1, At, B1); PG8_BAR;
            }
        }
        if constexpr (ALIGN_EPI) { if (wr == 0) PG8_BAR; }
        if constexpr (!Epi::AFTER_DRAIN) { E(acc, cur, wr, wc, fr, fq); S.done(cur); }
        if (!has_next) break;
#pragma unroll
        for (int a = 0; a < 2; ++a)
#pragma unroll
            for (int b = 0; b < 2; ++b)
#pragma unroll
                for (int m = 0; m < 4; ++m)
#pragma unroll
                    for (int n = 0; n < 2; ++n) acc[a][b][m][n] = (f32x4){0.f, 0.f, 0.f, 0.f};
        cur = nxt; cA = nA; cB = nB; ++ui;
        if constexpr (ALIGN_EPI) { if (wr == 1) PG8_BAR; }
    }
    PG8_WAIT_V(0);
    if constexpr (!ALIGN_EPI) { if (wr == 0) PG8_BAR; }
    PG8_BAR;
    if constexpr (Epi::AFTER_DRAIN) { E.fused(acc, cur, wr, wc, fr, fq, lds, wid, lane); S.done(cur); }
#undef PG8_SA
#undef PG8_SB
#undef PG8_STAGE
#undef PG8_LDA
#undef PG8_LDB
#undef PG8_MMA
#undef PG8_WAIT_V
#undef PG8_WAIT_L
#undef PG8_BAR
#undef PG8_SCHED
}
}
#define GAS __attribute__((address_space(1)))
#define LAS __attribute__((address_space(3)))
typedef unsigned short bf16;
typedef unsigned v4u __attribute__((ext_vector_type(4)));
typedef float f32x4 __attribute__((ext_vector_type(4)));
typedef short bf16x8 __attribute__((ext_vector_type(8)));
typedef GAS unsigned gu32;
typedef GAS unsigned long long gu64;
#define RLX_AGENT __ATOMIC_RELAXED, __HIP_MEMORY_SCOPE_AGENT
#define LDS_WAIT() asm volatile("s_waitcnt lgkmcnt(0)" ::: "memory")
#define VM_WAIT() asm volatile("s_waitcnt vmcnt(0)" ::: "memory")
__device__ __forceinline__ unsigned long long rt() { return __builtin_amdgcn_s_memrealtime(); }
__device__ __forceinline__ unsigned f2bf(float f) { unsigned u = __builtin_bit_cast(unsigned, f); return (u + 0x7fffu + ((u >> 16) & 1u)) >> 16; }
__device__ __forceinline__ unsigned pk2(float lo, float hi) { return f2bf(lo) | (f2bf(hi) << 16); }

#define XB_TMO      128
#define XB_XCNT(j)  (256  + 64 * (j))
#define XB_XSUB(j)  (1280 + 64 * (j))
#define XB_XGEN(j)  (2304 + 64 * (j))
#define XB_TOP      3328
#define XB_TOPGEN   3392
#define XCD_BAR_WORDS 3456
#define XB_SPIN_CAP (1u << 18)

__device__ __forceinline__ unsigned xb_ld(unsigned* p)              { return __hip_atomic_load(p, __ATOMIC_RELAXED, __HIP_MEMORY_SCOPE_AGENT); }
__device__ __forceinline__ unsigned xb_add(unsigned* p, unsigned v) { return __hip_atomic_fetch_add(p, v, __ATOMIC_RELAXED, __HIP_MEMORY_SCOPE_AGENT); }
__device__ __forceinline__ unsigned xb_xcc_id() { return (unsigned)__builtin_amdgcn_s_getreg((3 << 11) | 20) & 0xFu; }
#define XB_SPIN(cond, bar) do { unsigned _sp = 0; while (cond) { __builtin_amdgcn_s_sleep(1); \
    if ((++_sp & 255u) == 0u) { if (xb_ld(&(bar)[XB_TMO])) break; if (_sp > XB_SPIN_CAP) { atomicAdd(&(bar)[XB_TMO], 1u); break; } } } } while (0)

struct XcdBarrier {
    unsigned* bar; unsigned x;
    volatile LAS unsigned* st;
};

__device__ __forceinline__ XcdBarrier xcd_barrier_post(unsigned* bar, volatile LAS unsigned* st) {
    XcdBarrier b; b.bar = bar; b.x = xb_xcc_id(); b.st = st;
    if (threadIdx.x == 0) (void)xb_add(&bar[XB_XCNT(b.x)], 1u);
    return b;
}
__device__ __forceinline__ void xcd_barrier_complete(unsigned* bar, unsigned x, unsigned& nloc, unsigned& nx) {
    const unsigned G = gridDim.x * gridDim.y * gridDim.z;
    unsigned sum, cnt, mine, sp = 0u;
    for (;;) {
        sum = 0u; cnt = 0u; mine = 0u;
#pragma unroll
        for (unsigned j = 0; j < 16; ++j) { const unsigned c = xb_ld(&bar[XB_XCNT(j)]); sum += c; cnt += (c > 0u) ? 1u : 0u; mine = (j == x) ? c : mine; }
        if (sum == G) break;
        __builtin_amdgcn_s_sleep(1);
        if ((++sp & 255u) == 0u) { if (xb_ld(&bar[XB_TMO])) break; if (sp > XB_SPIN_CAP) { atomicAdd(&bar[XB_TMO], 1u); break; } }
    }
    nloc = mine > 0u ? mine : 1u; nx = cnt > 0u ? cnt : 1u;
}

__device__ __forceinline__ void xcd_barrier(const XcdBarrier& b) {
    asm volatile("s_waitcnt vmcnt(0)" ::: "memory");
    __syncthreads();
    if (threadIdx.x == 0) {
        unsigned* bar = b.bar;
        __builtin_amdgcn_s_waitcnt(0);
        unsigned nloc = b.st[0], nx = b.st[1];
        if (nloc == 0u) { xcd_barrier_complete(bar, b.x, nloc, nx); b.st[0] = nloc; b.st[1] = nx; }
        const unsigned old = xb_add(&bar[XB_XSUB(b.x)], 1u);
        const unsigned gen = old / nloc;
        if (old + 1u == (gen + 1u) * nloc) {
            __builtin_amdgcn_fence(__ATOMIC_RELEASE, "agent");
            asm volatile("s_waitcnt vmcnt(0)" ::: "memory");
            const unsigned og = xb_add(&bar[XB_TOP], 1u);
            const unsigned tg = og / nx;
            if (og + 1u == (tg + 1u) * nx) xb_add(&bar[XB_TOPGEN], 1u);
            else XB_SPIN(xb_ld(&bar[XB_TOPGEN]) == tg, bar);
            __builtin_amdgcn_fence(__ATOMIC_ACQUIRE, "agent");
            xb_add(&bar[XB_XGEN(b.x)], 1u);
            asm volatile("s_waitcnt vmcnt(0)" ::: "memory");
        } else {
            XB_SPIN(xb_ld(&bar[XB_XGEN(b.x)]) == gen, bar);
            __builtin_amdgcn_fence(__ATOMIC_ACQUIRE, "agent");
            asm volatile("s_waitcnt vmcnt(0)" ::: "memory");
        }
    }
    __syncthreads();
}
typedef unsigned u32x4 __attribute__((ext_vector_type(4)));

constexpr int M = 16384, D = 1024, DEPTH = 4, DFF = 2816, NFF = 2 * DFF;
constexpr int A_QKV = 1536, B_QKV = 2304, A_OUT = 1024, B_OUT = 512;
constexpr float C2 = 0.125f * 1.4426950408889634f;
constexpr float LOG2E = 1.4426950408889634f;
constexpr int NWAVES = 8;

constexpr size_t MiB = 1u << 20;
constexpr size_t WS_CTL = 0, CTL_ZERO_BYTES = 1 * MiB;
constexpr size_t WS_MOD = 1 * MiB;
constexpr size_t WS_BIAS = 1 * MiB + 128 * 1024;
constexpr size_t WS_SSQ1 = 1 * MiB + 256 * 1024;
constexpr size_t WS_SSQ2 = 1 * MiB + 512 * 1024;
constexpr size_t WS_BIASP = 2 * MiB;
constexpr size_t WS_LSE = 4 * MiB;
constexpr size_t WS_WB = 8 * MiB;
constexpr size_t WS_XB = 104 * MiB;
constexpr size_t WS_QKV = 136 * MiB;
constexpr size_t WS_O = 208 * MiB;
constexpr size_t WS_OG = 240 * MiB;
constexpr size_t WS_ACT = 288 * MiB;
constexpr size_t WS_END = 376 * MiB;
constexpr int NBIAS = 30208;
constexpr size_t WL_A = (size_t)A_QKV * D + (size_t)D * A_OUT + (size_t)NFF * D + (size_t)D * DFF;
constexpr size_t WL_B = (size_t)B_QKV * D + (size_t)D * B_OUT + (size_t)NFF * D + (size_t)D * DFF;
static_assert(WS_WB + (WL_A + WL_B) * 2 * 2 <= WS_XB, "weight copies fit");
__host__ __device__ __forceinline__ size_t wl_off(int layer) { return (size_t)(layer >> 1) * (WL_A + WL_B) + ((layer & 1) ? WL_A : 0); }
__host__ __device__ __forceinline__ int bias_off(int layer) { return (layer >> 1) * 15104 + ((layer & 1) ? 7168 : 0); }

constexpr int CW_BAR = 4096;
constexpr int RING_OFF = 0, RING_BYTES = 131072;
constexpr int WSF_OFF = RING_BYTES;
constexpr int LDSCTL_OFF = WSF_OFF + 2048, MISC_OFF = LDSCTL_OFF + 320;
constexpr int LDS_BYTES = 147456;
static_assert(MISC_OFF + 128 <= LDS_BYTES, "LDS map");


typedef float f32x16 __attribute__((ext_vector_type(16)));
typedef short s16x4 __attribute__((ext_vector_type(4)));
typedef float f32x2_t __attribute__((ext_vector_type(2))); typedef __bf16 bf16x2_t __attribute__((ext_vector_type(2)));
__device__ __forceinline__ unsigned cvtpk_s(float lo, float hi) { f32x2_t v = {lo, hi}; bf16x2_t b = __builtin_convertvector(v, bf16x2_t); return __builtin_bit_cast(unsigned, b); }
__device__ __forceinline__ int crow(int r, int hi) { return (r & 3) + 8 * (r >> 2) + 4 * hi; }
__device__ __forceinline__ s16x4 vtr(const LAS unsigned char* p) { return __builtin_bit_cast(s16x4, __builtin_amdgcn_ds_read_tr16_b64_v4i16((LAS s16x4*)p)); }
__device__ __forceinline__ float bf2f(unsigned short b) { return __builtin_bit_cast(float, (unsigned)b << 16); }

template <int HW, int NQT, bool SINK, int THR>
__device__ __forceinline__ void attn_unit(LAS unsigned char* lds, const bf16* __restrict__ qkv, const int pitch, const int c, const int d, const int U0, const int Ls,
                                          const int qcol0, const int kcol, const int vcol, const int hflat0, const float slope_den, const float* __restrict__ sink,
                                          bf16* __restrict__ O, const int opitch, const int ocol0, float* __restrict__ lse, const int lse_slot0) {
    constexpr int NKEYS = 32 * NQT + 2 * HW, NSLOT = NKEYS / 64, NKT = 1 + 2 * HW / 32, GPW = NQT / 2;
    constexpr int K_OFF = 0, V_OFF = NSLOT * 8192;
    static_assert(2 * NSLOT * 8192 <= RING_BYTES, "K/V fit the ring region");
    int tid_ = threadIdx.x; asm volatile("" : "+v"(tid_));
    const int tid = tid_, lane = tid & 63, r32 = lane & 31, hi = lane >> 5; const int wid = __builtin_amdgcn_readfirstlane(tid >> 6);
#pragma unroll
    for (int s = 0; s < NSLOT; ++s) {
        { int idx = U0 - HW + 64 * s + lane; idx = idx < 0 ? 0 : (idx > Ls - 1 ? Ls - 1 : idx); const size_t tok = (size_t)c + (size_t)d * idx;
          const bf16* src = qkv + tok * pitch + kcol + 8 * wid;
          __builtin_amdgcn_global_load_lds((const unsigned*)src, (LAS unsigned*)(lds + K_OFF + s * 8192 + wid * 1024), 16, 0, 0); }
        { int idx = U0 - HW + 64 * s + 16 * (wid & 3) + (lane >> 2); idx = idx < 0 ? 0 : (idx > Ls - 1 ? Ls - 1 : idx); const size_t tok = (size_t)c + (size_t)d * idx;
          const bf16* src = qkv + tok * pitch + vcol + 32 * (wid >> 2) + 8 * (lane & 3);
          __builtin_amdgcn_global_load_lds((const unsigned*)src, (LAS unsigned*)(lds + V_OFF + s * 8192 + wid * 1024), 16, 0, 0); }
    }
    asm volatile("s_waitcnt vmcnt(0)" ::: "memory");
    __syncthreads();
    LAS float* wsf = (LAS float*)(lds + WSF_OFF) + wid * 64;
    const int qt = wid % NQT, gbase = (wid / NQT) * GPW;
    const int uq = U0 + 32 * qt + r32;
    const size_t qtok = (size_t)c + (size_t)d * uq;
    const float lo_f = (float)((-uq) > -HW ? (-uq) : -HW), hi_f = (float)((Ls - 1 - uq) < HW ? (Ls - 1 - uq) : HW);
    const int vlane = ((lane >> 4) & 1) * 32 + (lane & 3) * 8 + (4 * hi + ((lane & 15) >> 2)) * 64;
    for (int gg = 0; gg < GPW; ++gg) {
        const int g = gbase + gg;
        const float slope = __builtin_amdgcn_exp2f(-8.0f * (float)(hflat0 + g + 1) / slope_den);
        const float nslope = -slope * LOG2E * (float)d;
        const bf16* qp = qkv + qtok * pitch + qcol0 + 64 * g + 8 * hi;
        bf16x8 qr[4];
#pragma unroll
        for (int d0 = 0; d0 < 4; ++d0) qr[d0] = *(const bf16x8*)(qp + 16 * d0);
        float m = SINK ? sink[g] * LOG2E : -1e30f;
        float l = (SINK && hi == 0) ? 1.0f : 0.0f;
        f32x16 o0 = {}, o1 = {};
        float dl = (float)(4 * hi - HW - r32);
        for (int jj = 0; jj < NKT; ++jj, dl += 32.0f) {
            const int j = qt + jj, slot = j >> 1, half = j & 1;
            const LAS unsigned char* kb = lds + K_OFF + slot * 8192 + hi * 1024 + (half * 32 + r32) * 16;
            f32x16 p = {};
#pragma unroll
            for (int d0 = 0; d0 < 4; ++d0) { const bf16x8 kf = *(const LAS bf16x8*)(kb + d0 * 2048); p = __builtin_amdgcn_mfma_f32_32x32x16_bf16(kf, qr[d0], p, 0, 0, 0); }
            float rm = -INFINITY;
#pragma unroll
            for (int r = 0; r < 16; ++r) { const float dd = dl + (float)((r & 3) + 8 * (r >> 2)); const bool ok = (dd >= lo_f) && (dd <= hi_f);
                const float s = ok ? __builtin_fmaf(__builtin_fabsf(dd), nslope, p[r]) : -INFINITY; p[r] = s; rm = __builtin_fmaxf(rm, s); }
            rm = __builtin_fmaxf(rm, __shfl_xor(rm, 32));
            if (__any(rm > m + (float)THR)) {
                const float mn = __builtin_fmaxf(m, rm); const float alpha = __builtin_amdgcn_exp2f(m - mn);
                l *= alpha; m = mn;
                if (hi == 0) wsf[r32] = alpha;
                asm volatile("s_waitcnt lgkmcnt(0)" ::: "memory");
#pragma unroll
                for (int r = 0; r < 16; ++r) { const float a = wsf[crow(r, hi)]; o0[r] *= a; o1[r] *= a; }
            }
            float ls = 0.f;
#pragma unroll
            for (int r = 0; r < 16; ++r) { p[r] = __builtin_amdgcn_exp2f(p[r] - m); ls += p[r]; }
            l += ls;
            u32x4 pw0, pw1;
            pw0[0] = cvtpk_s(p[0], p[1]); pw0[1] = cvtpk_s(p[2], p[3]); pw0[2] = cvtpk_s(p[4], p[5]); pw0[3] = cvtpk_s(p[6], p[7]);
            pw1[0] = cvtpk_s(p[8], p[9]); pw1[1] = cvtpk_s(p[10], p[11]); pw1[2] = cvtpk_s(p[12], p[13]); pw1[3] = cvtpk_s(p[14], p[15]);
            const bf16x8 pa0 = __builtin_bit_cast(bf16x8, pw0), pa1 = __builtin_bit_cast(bf16x8, pw1);
            const LAS unsigned char* vb = lds + V_OFF + slot * 8192 + (2 * half) * 1024 + vlane;
            {   const s16x4 a0 = vtr(vb), a1 = vtr(vb + 512), b0 = vtr(vb + 1024), b1 = vtr(vb + 1024 + 512);
                const s16x4 c0 = vtr(vb + 4096), c1 = vtr(vb + 4096 + 512), e0 = vtr(vb + 4096 + 1024), e1 = vtr(vb + 4096 + 1024 + 512);
                o0 = __builtin_amdgcn_mfma_f32_32x32x16_bf16(pa0, (bf16x8){a0[0], a0[1], a0[2], a0[3], a1[0], a1[1], a1[2], a1[3]}, o0, 0, 0, 0);
                o0 = __builtin_amdgcn_mfma_f32_32x32x16_bf16(pa1, (bf16x8){b0[0], b0[1], b0[2], b0[3], b1[0], b1[1], b1[2], b1[3]}, o0, 0, 0, 0);
                o1 = __builtin_amdgcn_mfma_f32_32x32x16_bf16(pa0, (bf16x8){c0[0], c0[1], c0[2], c0[3], c1[0], c1[1], c1[2], c1[3]}, o1, 0, 0, 0);
                o1 = __builtin_amdgcn_mfma_f32_32x32x16_bf16(pa1, (bf16x8){e0[0], e0[1], e0[2], e0[3], e1[0], e1[1], e1[2], e1[3]}, o1, 0, 0, 0); }
        }
        const float lt = l + __shfl_xor(l, 32);
        if (hi == 0) { wsf[32 + r32] = __builtin_amdgcn_rcpf(lt); if (lse) lse[qtok * 8 + lse_slot0 + g] = m + __builtin_amdgcn_logf(lt); }
        asm volatile("s_waitcnt lgkmcnt(0)" ::: "memory");
        const size_t tok0 = (size_t)c + (size_t)d * (size_t)(U0 + 32 * qt);
#pragma unroll
        for (int r = 0; r < 16; ++r) { const int qi = crow(r, hi); const float rl = wsf[32 + qi];
            bf16* op = O + (tok0 + (size_t)d * qi) * opitch + ocol0 + 64 * g + r32;
            op[0] = (bf16)(cvtpk_s(o0[r] * rl, 0.f) & 0xffffu); op[32] = (bf16)(cvtpk_s(o1[r] * rl, 0.f) & 0xffffu); }
        asm volatile("s_waitcnt lgkmcnt(0)" ::: "memory");
    }
    __syncthreads();
}

struct Frame {
    LAS unsigned char* lds; volatile LAS unsigned* MISC; gu32* ctl;
    int tid, lane, wave, vcu, G;
    const float *x, *cvec, *ada_w, *ada_b, *norm_mix, *norm_ffn, *ffn_w_in, *ffn_w_out, *a_w_in, *a_w_out, *a_sink, *b_w_in, *b_w_out, *final_norm;
    float* out; unsigned char* ws;
    float *mod, *bias, *ssq1, *ssq2, *biasp, *lse; bf16 *wb, *xb, *qkv, *o, *og, *act;
};
__device__ __forceinline__ float wave_sum(float v) {
#pragma unroll
    for (int o = 1; o < 64; o <<= 1) v += __shfl_xor(v, o);
    return v;
}

__device__ __forceinline__ void p0_mod_and_x(Frame& F) {
    LAS float* condl = (LAS float*)(F.lds + RING_OFF);
    for (int k = F.tid; k < D; k += NWAVES * 64) { const float cv = F.cvec[k]; condl[k] = cv / (1.0f + __expf(-cv)); }
    __syncthreads();
    const int NGW = F.G * NWAVES;
    for (int it = F.wave * F.G + F.vcu; it < DEPTH * 192; it += NGW) {
        const int layer = it / 192, n0 = 32 * (it % 192), kq = F.lane >> 3, c4 = F.lane & 7;
        const float* W = F.ada_w + (size_t)layer * D * 6 * D + n0 + 4 * c4;
        f32x4 acc = {0.f, 0.f, 0.f, 0.f};
#pragma unroll 8
        for (int i = 0; i < 128; ++i) { const int k = kq + 8 * i; const f32x4 w = *(const f32x4*)(W + (size_t)k * 6 * D); acc += w * condl[k]; }
#pragma unroll
        for (int o = 8; o < 64; o <<= 1) { acc.x += __shfl_xor(acc.x, o); acc.y += __shfl_xor(acc.y, o); acc.z += __shfl_xor(acc.z, o); acc.w += __shfl_xor(acc.w, o); }
        if (F.lane < 8) { const f32x4 b = *(const f32x4*)(F.ada_b + (size_t)layer * 6 * D + n0 + 4 * c4); *(f32x4*)(F.mod + (size_t)layer * 6 * D + n0 + 4 * c4) = acc + b; }
    }
    const int gw = F.vcu * NWAVES + F.wave;
    for (int m = gw; m < M; m += NGW) {
        const f32x4* xr = (const f32x4*)(F.x + (size_t)m * D) + F.lane;
        f32x4 v[4]; float s = 0.f;
#pragma unroll
        for (int j = 0; j < 4; ++j) { v[j] = xr[64 * j]; s += (v[j].x * v[j].x + v[j].y * v[j].y) + (v[j].z * v[j].z + v[j].w * v[j].w); }
        s = wave_sum(s);
        if (F.lane < 4) F.ssq1[(size_t)F.lane * M + m] = (F.lane == 0) ? s : 0.f;
        unsigned long long* o8 = (unsigned long long*)(F.xb + (size_t)m * D) + F.lane;
#pragma unroll
        for (int j = 0; j < 4; ++j) o8[64 * j] = (unsigned long long)cvtpk_s(v[j].x, v[j].y) | ((unsigned long long)cvtpk_s(v[j].z, v[j].w) << 32);
    }
}

__device__ __forceinline__ void prep_item(const float* __restrict__ W, const int K, const int N, const int k0, const int n0, bf16* __restrict__ WT, const int dest0,
                                          const float* __restrict__ nrm, const float* __restrict__ sc, const float* __restrict__ colmod, const float colconst,
                                          const float* __restrict__ sh, float* __restrict__ biasp_dst, LAS float* scr, const int lane) {
#pragma unroll 8
    for (int i = 0; i < 32; ++i) { const int kk = 2 * i + (lane >> 5); scr[kk * 33 + (lane & 31)] = W[(size_t)(k0 + kk) * N + n0 + (lane & 31)]; }
    asm volatile("s_waitcnt lgkmcnt(0)" ::: "memory");
    if (sh) {
        const int col = lane & 31, hb = (lane >> 5) * 32; float s = 0.f;
#pragma unroll 8
        for (int kk = 0; kk < 32; ++kk) s += sh[k0 + hb + kk] * scr[(hb + kk) * 33 + col];
        s += __shfl_xor(s, 32);
        if (lane < 32) biasp_dst[col] = s * colconst;
    }
    const int cch = lane & 7;
    float rsv[8];
#pragma unroll
    for (int e = 0; e < 8; ++e) { const int k = k0 + 8 * cch + e; rsv[e] = nrm ? nrm[k] * (1.0f + sc[k]) : 1.0f; }
#pragma unroll
    for (int j = 0; j < 4; ++j) { const int n = (lane >> 3) + 8 * j; const float cs = colconst * (colmod ? colmod[n0 + n] : 1.0f);
        const LAS float* s = scr + (8 * cch) * 33 + n;
        v4u o; o.x = cvtpk_s(s[0 * 33] * rsv[0] * cs, s[1 * 33] * rsv[1] * cs); o.y = cvtpk_s(s[2 * 33] * rsv[2] * cs, s[3 * 33] * rsv[3] * cs);
        o.z = cvtpk_s(s[4 * 33] * rsv[4] * cs, s[5 * 33] * rsv[5] * cs); o.w = cvtpk_s(s[6 * 33] * rsv[6] * cs, s[7 * 33] * rsv[7] * cs);
        *(v4u*)(WT + (size_t)(dest0 + n) * K + k0 + 8 * cch) = o; }
    asm volatile("s_waitcnt lgkmcnt(0)" ::: "memory");
}
__device__ __forceinline__ void p1_weights(Frame& F) {
    LAS float* scr = (LAS float*)(F.lds + RING_OFF + F.wave * 16384);
    const int gw = F.vcu * NWAVES + F.wave, NGW = F.G * NWAVES;
    constexpr int IA = 768 + 512 + 2816 + 1408, IB = 1152 + 256 + 2816 + 1408, NITEMS = 2 * (IA + IB);
    for (int it = gw; it < NITEMS; it += NGW) {
        int r = it % (IA + IB); const int t = r >= IA ? 1 : 0; if (t) r -= IA;
        const int layer = 2 * (it / (IA + IB)) + t, jl = layer >> 1;
        const float* mod = F.mod + (size_t)layer * 6 * D;
        const int n1 = t ? B_QKV : A_QKV, k2 = t ? B_OUT : A_OUT, dq = t ? 1536 : 1024;
        bf16* wl = F.wb + wl_off(layer);
        const int I1 = (n1 / 32) * 16, I2 = 32 * (k2 / 64), I3 = (NFF / 32) * 16;
        if (r < I1) {
            const int nblk = n1 / 32, nb = r % nblk, kb = r / nblk, n0 = 32 * nb;
            const float* W = t ? F.b_w_in + (size_t)jl * D * B_QKV : F.a_w_in + (size_t)jl * D * A_QKV;
            prep_item(W, D, n1, 64 * kb, n0, wl, n0, F.norm_mix + layer * D, mod + D, nullptr, n0 < dq ? C2 : 1.0f, mod, F.biasp + (size_t)kb * NBIAS + bias_off(layer) + n0, scr, F.lane);
            continue; }
        r -= I1;
        if (r < I2) {
            const int nb = r % 32, kb = r / 32, n0 = 32 * nb;
            const float* W = t ? F.b_w_out + (size_t)jl * B_OUT * D : F.a_w_out + (size_t)jl * A_OUT * D;
            prep_item(W, k2, D, 64 * kb, n0, wl + (size_t)n1 * D, n0, nullptr, nullptr, mod + 2 * D, 1.0f, nullptr, nullptr, scr, F.lane);
            continue; }
        r -= I2;
        if (r < I3) {
            const int nblk = NFF / 32, nb = r % nblk, kb = r / nblk, n0 = 32 * nb;
            const int dest0 = n0 < DFF ? 256 * (n0 / 128) + (n0 % 128) : 256 * ((n0 - DFF) / 128) + 128 + ((n0 - DFF) % 128);
            prep_item(F.ffn_w_in + (size_t)layer * D * NFF, D, NFF, 64 * kb, n0, wl + (size_t)n1 * D + (size_t)D * k2, dest0, F.norm_ffn + layer * D, mod + 4 * D, nullptr, 1.0f, mod + 3 * D,
                      F.biasp + (size_t)kb * NBIAS + bias_off(layer) + n1 + dest0, scr, F.lane);
            continue; }
        r -= I3;
        {
            const int nb = r % 32, kb = r / 32, n0 = 32 * nb;
            prep_item(F.ffn_w_out + (size_t)layer * DFF * D, DFF, D, 64 * kb, n0, wl + (size_t)n1 * D + (size_t)D * k2 + (size_t)NFF * D, n0, nullptr, nullptr, mod + 5 * D, 1.0f, nullptr, nullptr, scr, F.lane);
        }
    }
}
__device__ __forceinline__ void p2_bias_reduce(Frame& F) {
    const int idx = blockIdx.x * (NWAVES * 64) + F.tid;
    for (int i = idx; i < NBIAS; i += F.G * NWAVES * 64) { float s = 0.f;
#pragma unroll
        for (int kb = 0; kb < 16; ++kb) s += F.biasp[(size_t)kb * NBIAS + i];
        F.bias[i] = s; }
}
__device__ __forceinline__ void merge_groups(Frame& F) {
    const int gw = F.vcu * NWAVES + F.wave, NGW = F.G * NWAVES;
    for (int m = gw; m < M; m += NGW) {
        const int slot = F.lane >> 3;
        const float l0 = F.lse[(size_t)m * 8 + slot], l1 = F.lse[(size_t)M * 8 + (size_t)m * 8 + slot], l2 = F.lse[(size_t)2 * M * 8 + (size_t)m * 8 + slot];
        const float mx = __builtin_fmaxf(__builtin_fmaxf(l0, l1), l2);
        float w0 = __builtin_amdgcn_exp2f(l0 - mx), w1 = __builtin_amdgcn_exp2f(l1 - mx), w2 = __builtin_amdgcn_exp2f(l2 - mx);
        const float inv = __builtin_amdgcn_rcpf(w0 + w1 + w2); w0 *= inv; w1 *= inv; w2 *= inv;
        const v4u a = *(const v4u*)(F.og + (size_t)m * 512 + 8 * F.lane), b = *(const v4u*)(F.og + (size_t)M * 512 + (size_t)m * 512 + 8 * F.lane), cc = *(const v4u*)(F.og + (size_t)2 * M * 512 + (size_t)m * 512 + 8 * F.lane);
        v4u o;
#pragma unroll
        for (int e = 0; e < 4; ++e) {
            const float lo = w0 * __builtin_bit_cast(float, a[e] << 16) + w1 * __builtin_bit_cast(float, b[e] << 16) + w2 * __builtin_bit_cast(float, cc[e] << 16);
            const float hi = w0 * __builtin_bit_cast(float, a[e] & 0xffff0000u) + w1 * __builtin_bit_cast(float, b[e] & 0xffff0000u) + w2 * __builtin_bit_cast(float, cc[e] & 0xffff0000u);
            o[e] = cvtpk_s(lo, hi); }
        *(v4u*)(F.o + (size_t)m * 512 + 8 * F.lane) = o;
    }
}
__device__ __forceinline__ void final_norm(Frame& F) {
    const int gw = F.vcu * NWAVES + F.wave, NGW = F.G * NWAVES;
    for (int m = gw; m < M; m += NGW) {
        const float rs = pg8::row_rstd(F.ssq1, m);
        f32x4* xr = (f32x4*)(F.out + (size_t)m * D) + F.lane; const f32x4* fw = (const f32x4*)F.final_norm + F.lane;
#pragma unroll
        for (int j = 0; j < 4; ++j) { const f32x4 v = xr[64 * j]; xr[64 * j] = v * rs * fw[64 * j]; }
    }
}

#ifndef MK_MULTI
#define MK_MULTI 0
#endif
#ifndef ATT_THR
#define ATT_THR 0
#endif
constexpr int NPHASES = 3 + 6 * DEPTH + 1;
struct Args { const float* in[14]; float* out; unsigned char* ws; int ph_lo, ph_hi; };
__global__ void __launch_bounds__(NWAVES * 64, 2) fwd_kernel(Args args) {
    extern __shared__ __attribute__((aligned(16))) unsigned char lds_raw[];
    Frame F;
    F.lds = (LAS unsigned char*)lds_raw; F.MISC = (volatile LAS unsigned*)(F.lds + MISC_OFF);
    F.tid = threadIdx.x; F.lane = F.tid & 63; F.wave = __builtin_amdgcn_readfirstlane(F.tid >> 6);
    F.G = gridDim.x; { const int bx = blockIdx.x; F.vcu = (F.G % 8 == 0) ? (bx % 8) * (F.G / 8) + bx / 8 : bx; }
    unsigned char* ws = args.ws; F.ws = ws; F.ctl = (gu32*)(ws + WS_CTL);
    F.x = args.in[0]; F.cvec = args.in[1]; F.ada_w = args.in[2]; F.ada_b = args.in[3]; F.norm_mix = args.in[4]; F.norm_ffn = args.in[5]; F.ffn_w_in = args.in[6]; F.ffn_w_out = args.in[7];
    F.a_w_in = args.in[8]; F.a_w_out = args.in[9]; F.a_sink = args.in[10]; F.b_w_in = args.in[11]; F.b_w_out = args.in[12]; F.final_norm = args.in[13]; F.out = args.out;
    F.mod = (float*)(ws + WS_MOD); F.bias = (float*)(ws + WS_BIAS); F.ssq1 = (float*)(ws + WS_SSQ1); F.ssq2 = (float*)(ws + WS_SSQ2); F.biasp = (float*)(ws + WS_BIASP); F.lse = (float*)(ws + WS_LSE);
    F.wb = (bf16*)(ws + WS_WB); F.xb = (bf16*)(ws + WS_XB); F.qkv = (bf16*)(ws + WS_QKV); F.o = (bf16*)(ws + WS_O); F.og = (bf16*)(ws + WS_OG); F.act = (bf16*)(ws + WS_ACT);
    for (int u = F.tid; u < (LDS_BYTES - LDSCTL_OFF) / 4; u += NWAVES * 64) ((LAS unsigned*)(F.lds + LDSCTL_OFF))[u] = 0u;
    __syncthreads();
    const int lo = args.ph_lo, hi = args.ph_hi;
    XcdBarrier bar; bar.bar = (unsigned*)(F.ctl + CW_BAR); bar.x = 0; bar.st = nullptr;
    if (hi - lo > 1) bar = xcd_barrier_post((unsigned*)(F.ctl + CW_BAR), F.MISC + 8);
#define RUN(p) (lo <= (p) && (p) < hi)
#define SEAM(p) do { if (RUN(p) && RUN((p) + 1)) xcd_barrier(bar); } while (0)

    if (RUN(0)) { p0_mod_and_x(F); } SEAM(0);
    if (RUN(1)) { p1_weights(F); } SEAM(1);
    if (RUN(2)) { p2_bias_reduce(F); } SEAM(2);

    for (int layer = 0; layer < DEPTH; ++layer) {
        const int pb = 3 + 6 * layer, t = layer & 1, jl = layer >> 1;
        const int n1 = t ? B_QKV : A_QKV, k2 = t ? B_OUT : A_OUT;
        const bf16* wl = F.wb + wl_off(layer);
        const float* bias1 = F.bias + bias_off(layer);
        if (RUN(pb)) {
            pg8::Gemm g{F.xb, wl, M, n1, D}; pg8::StaticOrder S; S.init(M, n1, F.G, (int)blockIdx.x);
            pg8::EpiQKV E{F.qkv, n1, bias1, F.ssq1};
            pg8::gemm_phase<pg8::EpiQKV, pg8::StaticOrder, true, true>(F.lds + RING_OFF, g, S, E);
        }
        SEAM(pb);
        if (RUN(pb + 1)) {
            if (t == 0) {
                for (int u = F.vcu; u < 256; u += F.G) { const int qb = u >> 2, hkv = u & 3;
                    attn_unit<128, 8, true, ATT_THR>(F.lds + RING_OFF, F.qkv, A_QKV, 0, 1, 256 * qb, M, 256 * hkv, 1024 + 64 * hkv, 1280 + 64 * hkv, 4 * hkv, 16.0f, F.a_sink + jl * 16 + 4 * hkv,
                                                   F.o, 1024, 256 * hkv, nullptr, 0); }
            } else {
                for (int u = F.vcu; u < 768; u += F.G) { const int gi = u >> 8, rem = u & 255, hkv = rem & 1, cb = rem >> 1; const int dd = 1 << (2 * gi), cc = cb & (dd - 1), blk = cb >> (2 * gi);
                    attn_unit<64, 4, false, ATT_THR>(F.lds + RING_OFF, F.qkv, B_QKV, cc, dd, 128 * blk, M >> (2 * gi), (gi * 8 + hkv * 4) * 64, 1536 + (gi * 2 + hkv) * 64, 1920 + (gi * 2 + hkv) * 64,
                                                   gi * 8 + hkv * 4, 24.0f, nullptr, F.og + (size_t)gi * M * 512, 512, 256 * hkv, F.lse + (size_t)gi * M * 8, 4 * hkv); }
            }
        }
        SEAM(pb + 1);
        if (RUN(pb + 2)) { if (t == 1) merge_groups(F); }
        if (t == 1) SEAM(pb + 2);
        if (RUN(pb + 3)) {
            pg8::Gemm g{F.o, wl + (size_t)n1 * D, M, D, k2}; pg8::StaticOrder S; S.init(M, D, F.G, (int)blockIdx.x);
            pg8::EpiResid E{layer == 0 ? F.x : F.out, F.out, F.xb, F.ssq2};
            pg8::gemm_phase<pg8::EpiResid, pg8::StaticOrder, false, true>(F.lds + RING_OFF, g, S, E);
        }
        SEAM(pb + 3);
        if (RUN(pb + 4)) {
            pg8::Gemm g{F.xb, wl + (size_t)n1 * D + (size_t)D * k2, M, NFF, D}; pg8::StaticOrder S; S.init(M, NFF, F.G, (int)blockIdx.x);
            pg8::EpiSwiGLU E{F.act, DFF, bias1 + n1, F.ssq2};
            pg8::gemm_phase<pg8::EpiSwiGLU, pg8::StaticOrder, true, true>(F.lds + RING_OFF, g, S, E);
        }
        SEAM(pb + 4);
        if (RUN(pb + 5)) {
            pg8::Gemm g{F.act, wl + (size_t)n1 * D + (size_t)D * k2 + (size_t)NFF * D, M, D, DFF}; pg8::StaticOrder S; S.init(M, D, F.G, (int)blockIdx.x);
            pg8::EpiResid E{F.out, F.out, F.xb, F.ssq1};
            pg8::gemm_phase<pg8::EpiResid, pg8::StaticOrder, false, true>(F.lds + RING_OFF, g, S, E);
        }
        SEAM(pb + 5);
    }
    if (RUN(NPHASES - 1)) final_norm(F);
#undef RUN
#undef SEAM
}

extern "C" void kernel_launch(void* const* d_in, const int* in_sizes, int n_in, void* d_out, int out_size, void* d_ws, size_t ws_size, hipStream_t stream) {
    static int grid = 0;
    if (grid == 0) {
        if (n_in != 14 || in_sizes[0] != M * D || out_size != M * D || ws_size < WS_END) { fprintf(stderr, "kernel_launch: unexpected shapes / workspace (n_in %d, in0 %d, out %d, ws %zu)\n", n_in, n_in > 0 ? in_sizes[0] : -1, out_size, ws_size); grid = -1; return; }
        int dev = 0, cus = 0, per_cu = 0;
        if (hipGetDevice(&dev) != hipSuccess || hipDeviceGetAttribute(&cus, hipDeviceAttributeMultiprocessorCount, dev) != hipSuccess) { grid = -1; return; }
        if (hipFuncSetAttribute((const void*)fwd_kernel, hipFuncAttributeMaxDynamicSharedMemorySize, LDS_BYTES) != hipSuccess) { fprintf(stderr, "kernel_launch: hipFuncSetAttribute failed\n"); grid = -1; return; }
        if (hipOccupancyMaxActiveBlocksPerMultiprocessor(&per_cu, (const void*)fwd_kernel, NWAVES * 64, LDS_BYTES) != hipSuccess || per_cu < 1) fprintf(stderr, "kernel_launch: occupancy query reports %d blocks per CU\n", per_cu);
        (void)hipGetLastError();
        grid = cus;
        if (grid != 256) fprintf(stderr, "kernel_launch: %d CUs (built for 256)\n", grid);
    }
    if (grid < 0) return;
    (void)hipMemsetAsync((char*)d_ws + WS_CTL, 0, CTL_ZERO_BYTES, stream);
    Args a{};
    for (int i = 0; i < 14; ++i) a.in[i] = (const float*)d_in[i];
    a.out = (float*)d_out; a.ws = (unsigned char*)d_ws;
#if MK_MULTI
    for (int p = 0; p < NPHASES; ++p) {
        if (p >= 3 && p < NPHASES - 1 && ((p - 3) % 6) == 2 && (((p - 3) / 6) & 1) == 0) continue;
        a.ph_lo = p; a.ph_hi = p + 1;
        hipLaunchKernelGGL(fwd_kernel, dim3(grid), dim3(NWAVES * 64), LDS_BYTES, stream, a);
    }
#else
    a.ph_lo = 0; a.ph_hi = NPHASES;
    hipLaunchKernelGGL(fwd_kernel, dim3(grid), dim3(NWAVES * 64), LDS_BYTES, stream, a);
#endif
}
```

```cpp
#include <hip/hip_runtime.h>
#include <cstdio>
#include <cstdint>
namespace pg8 {
#define PG8_LAS __attribute__((address_space(3)))
typedef unsigned short bf16_t;
typedef short bf16x8 __attribute__((ext_vector_type(8)));
typedef float f32x4 __attribute__((ext_vector_type(4)));
typedef unsigned u32x4 __attribute__((ext_vector_type(4)));
constexpr int BM = 256, BK = 64, HALF = 128, HTB = HALF * BK * 2  , STAGE_BYTES = 8 * HTB, NXCD = 8, WGM = 8;

__host__ __device__ __forceinline__ int lds_byte(int r, int c) { const int st = (r >> 4) * 2 + (c >> 5), rr = r & 15, cc = c & 31, ob = rr * 64 + cc * 2; return st * 1024 + (ob ^ (((ob >> 9) & 1) << 5)); }
__host__ __device__ __forceinline__ void stage_rc(int b, int& R, int& C) { const int st = b / 1024, sb = b % 1024, swz = sb ^ (((sb >> 9) & 1) << 5); R = (st >> 1) * 16 + swz / 64; C = (st & 1) * 32 + (swz % 64) / 2; }
__host__ __device__ __forceinline__ int perm32(int rho) { const int n = rho >> 4, i = rho & 15; return 8 * (i >> 2) + 4 * n + (i & 3); }

struct Unit { int pm, pn; };
struct Gemm { const bf16_t* A; const bf16_t* Bt; int M, N, K; };

struct StaticOrder {
    int nM, nN, nwg, G, c;
    __host__ __device__ void init(int M, int N, int G_, int c_) { nM = M / BM; nN = N / BM; nwg = nM * nN; G = G_; c = c_; }
    __host__ __device__ bool next(int i, Unit& u) const {
        const long L = (long)i * G + c; if (L >= nwg) return false;
        int wgid = (int)L; { const int q = nwg / NXCD, r = nwg % NXCD, xcd = wgid % NXCD, off = wgid / NXCD; wgid = (xcd < r ? xcd * (q + 1) : r * (q + 1) + (xcd - r) * q) + off; }
        const int nig = WGM * nN, gid = wgid / nig, fm = gid * WGM, gsz = (nM - fm) < WGM ? (nM - fm) : WGM;
        u.pm = fm + ((wgid % nig) % gsz); u.pn = (wgid % nig) / gsz; return true;
    }
    __device__ __forceinline__ void a_ready(const Unit&) const {}
    __device__ __forceinline__ void done(const Unit&) const {}
};

__device__ __forceinline__ unsigned cvt_pk_bf16(float lo, float hi) { unsigned r; asm volatile("v_cvt_pk_bf16_f32 %0, %1, %2" : "=v"(r) : "v"(lo), "v"(hi)); return r; }
constexpr int MROWS = 16384;
constexpr float RMS_EPS_F = 1e-6f;
__device__ __forceinline__ float row_rstd(const float* ssq, int row) {
    const f32x4 v = *(const f32x4*)(ssq + (size_t)row * 4);
    return __builtin_amdgcn_rsqf(((v[0] + v[1]) + (v[2] + v[3])) * (1.0f / 1024.0f) + RMS_EPS_F);
}
struct EpiQKV {
    static constexpr bool PERM = true, AFTER_DRAIN = false;
    bf16_t* O; int ldc; const float* bias; const float* ssq;
    __device__ __forceinline__ void operator()(const f32x4 (&acc)[2][2][4][2], const Unit& u, int wr, int wc, int fr, int fq) const {
        const int row0 = u.pm * BM + wr * 64 + fr; const int col0 = u.pn * BM + wc * 32 + 8 * fq;
        f32x4 bv[2][2];
#pragma unroll
        for (int bj = 0; bj < 2; ++bj)
#pragma unroll
            for (int n = 0; n < 2; ++n) bv[bj][n] = *(const f32x4*)(bias + col0 + bj * HALF + 4 * n);
#pragma unroll
        for (int ai = 0; ai < 2; ++ai)
#pragma unroll
            for (int m = 0; m < 4; ++m) { const int row = row0 + ai * HALF + m * 16; const float rs = row_rstd(ssq, row); bf16_t* rowp = O + (size_t)row * ldc + col0;
#pragma unroll
                for (int bj = 0; bj < 2; ++bj) { const f32x4 v0 = acc[ai][bj][m][0] * rs + bv[bj][0], v1 = acc[ai][bj][m][1] * rs + bv[bj][1];
                    u32x4 w; w.x = cvt_pk_bf16(v0[0], v0[1]); w.y = cvt_pk_bf16(v0[2], v0[3]); w.z = cvt_pk_bf16(v1[0], v1[1]); w.w = cvt_pk_bf16(v1[2], v1[3]);
                    *(u32x4*)(rowp + bj * HALF) = w; } }
    }
};
__device__ __forceinline__ float silu_mul(float g, float up) { const float e = __builtin_amdgcn_exp2f(g * -1.4426950408889634f); return g * up * __builtin_amdgcn_rcpf(1.0f + e); }
struct EpiSwiGLU {
    static constexpr bool PERM = true, AFTER_DRAIN = false;
    bf16_t* O; int ldo; const float* bias; const float* ssq;
    __device__ __forceinline__ void operator()(const f32x4 (&acc)[2][2][4][2], const Unit& u, int wr, int wc, int fr, int fq) const {
        const int row0 = u.pm * BM + wr * 64 + fr; const int col0 = u.pn * BM + wc * 32 + 8 * fq; const int ocol = u.pn * HALF + wc * 32 + 8 * fq;
        f32x4 bv[2][2];
#pragma unroll
        for (int bj = 0; bj < 2; ++bj)
#pragma unroll
            for (int n = 0; n < 2; ++n) bv[bj][n] = *(const f32x4*)(bias + col0 + bj * HALF + 4 * n);
#pragma unroll
        for (int ai = 0; ai < 2; ++ai)
#pragma unroll
            for (int m = 0; m < 4; ++m) { const int row = row0 + ai * HALF + m * 16; const float rs = row_rstd(ssq, row);
                const f32x4 g0 = acc[ai][0][m][0] * rs + bv[0][0], g1 = acc[ai][0][m][1] * rs + bv[0][1], u0 = acc[ai][1][m][0] * rs + bv[1][0], u1 = acc[ai][1][m][1] * rs + bv[1][1];
                u32x4 w; w.x = cvt_pk_bf16(silu_mul(g0[0], u0[0]), silu_mul(g0[1], u0[1])); w.y = cvt_pk_bf16(silu_mul(g0[2], u0[2]), silu_mul(g0[3], u0[3]));
                w.z = cvt_pk_bf16(silu_mul(g1[0], u1[0]), silu_mul(g1[1], u1[1])); w.w = cvt_pk_bf16(silu_mul(g1[2], u1[2]), silu_mul(g1[3], u1[3]));
                *(u32x4*)(O + (size_t)row * ldo + ocol) = w; }
    }
};
struct EpiResid {
    static constexpr bool PERM = true, AFTER_DRAIN = true;
    const float* xin; float* xout; bf16_t* xb; float* ssq_out;
    __device__ __forceinline__ void fused(f32x4 (&acc)[2][2][4][2], const Unit& u, int wr, int wc, int fr, int fq, PG8_LAS unsigned char* lds, int wid, int lane) const {
        PG8_LAS float* P = (PG8_LAS float*)lds;
        const int col0 = u.pn * BM + wc * 32 + 8 * fq;
#pragma unroll
        for (int ai = 0; ai < 2; ++ai)
#pragma unroll
            for (int m = 0; m < 4; ++m) { const int rl = ai * HALF + wr * 64 + m * 16 + fr; const size_t off = (size_t)(u.pm * BM + rl) * 1024 + col0; float s = 0.f;
#pragma unroll
                for (int bj = 0; bj < 2; ++bj) {
                    const f32x4 x0 = *(const f32x4*)(xin + off + bj * HALF), x1 = *(const f32x4*)(xin + off + bj * HALF + 4);
                    const f32x4 v0 = x0 + acc[ai][bj][m][0], v1 = x1 + acc[ai][bj][m][1];
                    *(f32x4*)(xout + off + bj * HALF) = v0; *(f32x4*)(xout + off + bj * HALF + 4) = v1;
                    s += (v0[0] * v0[0] + v0[1] * v0[1]) + (v0[2] * v0[2] + v0[3] * v0[3]) + (v1[0] * v1[0] + v1[1] * v1[1]) + (v1[2] * v1[2] + v1[3] * v1[3]);
                    u32x4 w; w.x = cvt_pk_bf16(v0[0], v0[1]); w.y = cvt_pk_bf16(v0[2], v0[3]); w.z = cvt_pk_bf16(v1[0], v1[1]); w.w = cvt_pk_bf16(v1[2], v1[3]);
                    *(u32x4*)(xb + off + bj * HALF) = w; }
                s += __shfl_xor(s, 16); s += __shfl_xor(s, 32);
                if (fq == 0) P[rl * 4 + wc] = s;
                if (m & 1) asm volatile("" ::: "memory"); }
        asm volatile("s_waitcnt lgkmcnt(0)" ::: "memory"); __builtin_amdgcn_s_barrier(); asm volatile("" ::: "memory");
        if (lane < 32) { const int row = wid * 32 + lane; const float t = (P[row * 4 + 0] + P[row * 4 + 1]) + (P[row * 4 + 2] + P[row * 4 + 3]);
            ssq_out[(size_t)(u.pm * BM + row) * 4 + u.pn] = t; }
        asm volatile("s_waitcnt lgkmcnt(0)" ::: "memory"); __builtin_amdgcn_s_barrier(); asm volatile("" ::: "memory");
    }
};

struct EpiNull {
    static constexpr bool PERM = true, AFTER_DRAIN = false;
    __device__ __forceinline__ void operator()(const f32x4 (&acc)[2][2][4][2], const Unit& u, int wr, int wc, int fr, int fq) const {
#pragma unroll
        for (int ai = 0; ai < 2; ++ai)
#pragma unroll
            for (int bj = 0; bj < 2; ++bj)
#pragma unroll
                for (int m = 0; m < 4; ++m)
#pragma unroll
                    for (int n = 0; n < 2; ++n) asm volatile("" :: "v"(acc[ai][bj][m][n]));
    }
};
template <class Epi, class Sched, bool ALIGN_EPI = false, bool SP2 = false>
__device__ __forceinline__ void gemm_phase(PG8_LAS unsigned char* lds, const Gemm g, const Sched& S, const Epi& E) {
    int tid_ = threadIdx.x; asm volatile("" : "+v"(tid_));
    const int tid = tid_, wid = __builtin_amdgcn_readfirstlane(tid >> 6), lane = tid & 63, wr = wid >> 2, wc = wid & 3, fr = lane & 15, fq = lane >> 4;
    const int K = g.K, nt = K / BK;
    unsigned voffA[2], voffB[2];
#pragma unroll
    for (int i = 0; i < 2; ++i) { int R, C; stage_rc(tid * 16 + i * 8192, R, C); const int Rb = Epi::PERM ? ((R & ~31) + perm32(R & 31)) : R;
        voffA[i] = (unsigned)(R * K + C) * 2u; voffB[i] = (unsigned)(Rb * K + C) * 2u; }
    const size_t kstep = (size_t)(BK * 2);
    const size_t hstep = (size_t)HALF * K * 2;
    const size_t tstep = 2 * hstep;
    const unsigned ldsw = (unsigned)wid * 1024u;
    const int aoff = lds_byte(wr * 64 + fr, fq * 8), boff = lds_byte(wc * 32 + fr, fq * 8);
#define PG8_SA(b, h) (((b) * 2 + (h)) * HTB)
#define PG8_SB(b, h) ((4 + (b) * 2 + (h)) * HTB)
#define PG8_STAGE(bufoff, gbase, voff) do { _Pragma("unroll") for (int _i = 0; _i < 2; ++_i) \
        __builtin_amdgcn_global_load_lds((const unsigned*)((const char*)(gbase) + (voff)[_i]), (PG8_LAS unsigned*)(lds + (bufoff) + ldsw + _i * 8192), 16, 0, 0); } while (0)
#define PG8_LDA(dst, b, h) do { _Pragma("unroll") for (int m = 0; m < 4; ++m) _Pragma("unroll") for (int k = 0; k < 2; ++k) dst[m][k] = *(const PG8_LAS bf16x8*)(lds + PG8_SA(b, h) + aoff + m * 2048 + k * 1024); } while (0)
#define PG8_LDB(dst, b, h) do { _Pragma("unroll") for (int n = 0; n < 2; ++n) _Pragma("unroll") for (int k = 0; k < 2; ++k) dst[n][k] = *(const PG8_LAS bf16x8*)(lds + PG8_SB(b, h) + boff + n * 2048 + k * 1024); } while (0)
#define PG8_MMA(ai, bj, At, Bt) do { __builtin_amdgcn_s_setprio(1); _Pragma("unroll") for (int m = 0; m < 4; ++m) _Pragma("unroll") for (int n = 0; n < 2; ++n) _Pragma("unroll") for (int k = 0; k < 2; ++k) \
        acc[ai][bj][m][n] = __builtin_amdgcn_mfma_f32_16x16x32_bf16(Bt[n][k], At[m][k], acc[ai][bj][m][n], 0, 0, 0); __builtin_amdgcn_s_setprio(0); } while (0)
#define PG8_WAIT_V(n) asm volatile("s_waitcnt vmcnt(" #n ")" ::: "memory")
#define PG8_WAIT_L(n) asm volatile("s_waitcnt lgkmcnt(" #n ")" ::: "memory")
#define PG8_BAR __builtin_amdgcn_s_barrier()
#define PG8_SCHED __builtin_amdgcn_sched_barrier(0)
    Unit cur, nxt; int ui = 0;
    if (!S.next(0, cur)) return;
    f32x4 acc[2][2][4][2];
#pragma unroll
    for (int a = 0; a < 2; ++a)
#pragma unroll
        for (int b = 0; b < 2; ++b)
#pragma unroll
            for (int m = 0; m < 4; ++m)
#pragma unroll
                for (int n = 0; n < 2; ++n) acc[a][b][m][n] = (f32x4){0.f, 0.f, 0.f, 0.f};
    bf16x8 At[4][2], B0[2][2], B1[2][2];
    const char* cA = (const char*)g.A + (size_t)cur.pm * tstep; const char* cB = (const char*)g.Bt + (size_t)cur.pn * tstep;
    S.a_ready(cur);
    if constexpr (SP2) {
        PG8_STAGE(PG8_SB(0, 0), cB, voffB); PG8_STAGE(PG8_SB(0, 1), cB + hstep, voffB); PG8_STAGE(PG8_SA(0, 0), cA, voffA); PG8_STAGE(PG8_SA(0, 1), cA + hstep, voffA);
        if (wr == 1) PG8_BAR;
        PG8_WAIT_V(2); PG8_BAR;
        PG8_STAGE(PG8_SB(1, 0), cB + kstep, voffB); PG8_STAGE(PG8_SA(1, 0), cA + kstep, voffA); PG8_STAGE(PG8_SB(1, 1), cB + hstep + kstep, voffB);
        PG8_WAIT_V(6); PG8_BAR;
    } else {
        PG8_STAGE(PG8_SB(0, 0), cB, voffB); PG8_STAGE(PG8_SA(0, 0), cA, voffA); PG8_STAGE(PG8_SB(0, 1), cB + hstep, voffB); PG8_STAGE(PG8_SA(0, 1), cA + hstep, voffA);
        if (wr == 1) PG8_BAR;
        PG8_WAIT_V(4); PG8_BAR;
        PG8_STAGE(PG8_SB(1, 0), cB + kstep, voffB); PG8_STAGE(PG8_SA(1, 0), cA + kstep, voffA); PG8_STAGE(PG8_SB(1, 1), cB + hstep + kstep, voffB);
        PG8_WAIT_V(6); PG8_BAR;
    }
    for (;;) {
        const bool has_next = S.next(ui + 1, nxt);
        const char* nA = has_next ? (const char*)g.A + (size_t)nxt.pm * tstep : cA; const char* nB = has_next ? (const char*)g.Bt + (size_t)nxt.pn * tstep : cB;
        for (int t = 0; t < nt; t += 2) {
            const bool last = (t == nt - 2);
            const char* a1 = cA + (size_t)(t + 1) * kstep;
            const char* a2 = last ? nA : cA + (size_t)(t + 2) * kstep; const char* b2 = last ? nB : cB + (size_t)(t + 2) * kstep;
            const char* a3 = a2 + kstep; const char* b3 = b2 + kstep;
            if (last && has_next) S.a_ready(nxt);
            if constexpr (SP2) {
            PG8_LDB(B0, 0, 0); PG8_LDB(B1, 0, 1); PG8_SCHED; PG8_LDA(At, 0, 0); PG8_STAGE(PG8_SA(1, 1), a1 + hstep, voffA);
            PG8_WAIT_V(8); PG8_WAIT_L(0); PG8_BAR; PG8_MMA(0, 0, At, B0); PG8_MMA(0, 1, At, B1); PG8_BAR; PG8_SCHED;
            PG8_LDA(At, 0, 1); PG8_STAGE(PG8_SB(0, 0), b2, voffB); PG8_STAGE(PG8_SB(0, 1), b2 + hstep, voffB); PG8_STAGE(PG8_SA(0, 0), a2, voffA);
            PG8_WAIT_V(8); PG8_WAIT_L(0); PG8_BAR; PG8_MMA(1, 0, At, B0); PG8_MMA(1, 1, At, B1); PG8_BAR; PG8_SCHED;
            PG8_LDB(B0, 1, 0); PG8_LDB(B1, 1, 1); PG8_SCHED; PG8_LDA(At, 1, 0); PG8_STAGE(PG8_SA(0, 1), a2 + hstep, voffA);
            PG8_WAIT_V(8); PG8_WAIT_L(0); PG8_BAR; PG8_MMA(0, 0, At, B0); PG8_MMA(0, 1, At, B1); PG8_BAR; PG8_SCHED;
            PG8_LDA(At, 1, 1); PG8_STAGE(PG8_SB(1, 0), b3, voffB); PG8_STAGE(PG8_SB(1, 1), b3 + hstep, voffB); PG8_STAGE(PG8_SA(1, 0), a3, voffA);
            PG8_WAIT_V(8); PG8_WAIT_L(0); PG8_BAR; PG8_MMA(1, 0, At, B0); PG8_MMA(1, 1, At, B1); PG8_BAR; PG8_SCHED;
            } else {
            PG8_LDB(B0, 0, 0); PG8_SCHED; PG8_LDA(At, 0, 0); PG8_STAGE(PG8_SA(1, 1), a1 + hstep, voffA);
            PG8_WAIT_L(8); PG8_BAR; PG8_WAIT_L(0); PG8_MMA(0, 0, At, B0); PG8_BAR; PG8_SCHED;
            PG8_LDB(B1, 0, 1); PG8_STAGE(PG8_SB(0, 0), b2, voffB);
            PG8_BAR; PG8_WAIT_L(0); PG8_MMA(0, 1, At, B1); PG8_BAR;
            PG8_LDA(At, 0, 1); PG8_STAGE(PG8_SA(0, 0), a2, voffA);
            PG8_BAR; PG8_WAIT_L(0); PG8_MMA(1, 0, At, B0); PG8_BAR; PG8_SCHED;
            PG8_STAGE(PG8_SB(0, 1), b2 + hstep, voffB);
            PG8_WAIT_V(6); PG8_BAR; PG8_MMA(1, 1, At, B1); PG8_BAR;
            PG8_LDB(B0, 1, 0); PG8_SCHED; PG8_LDA(At, 1, 0); PG8_STAGE(PG8_SA(0, 1), a2 + hstep, voffA);
            PG8_WAIT_L(8); PG8_BAR; PG8_WAIT_L(0); PG8_MMA(0, 0, At, B0); PG8_BAR; PG8_SCHED;
            PG8_LDB(B1, 1, 1); PG8_STAGE(PG8_SB(1, 0), b3, voffB);
            PG8_BAR; PG8_WAIT_L(0); PG8_MMA(0, 1, At, B1); PG8_BAR;
            PG8_LDA(At, 1, 1); PG8_STAGE(PG8_SA(1, 0), a3, voffA);
            PG8_BAR; PG8_WAIT_L(0); PG8_MMA(1, 0, At, B0); PG8_BAR; PG8_SCHED;
            PG8_STAGE(PG8_SB(1, 1), b3 + hstep, voffB);
            PG8_WAIT_V(6); PG8_BAR; PG8_MMA(1, 1, At, B1); PG8_BAR;
            }
        }
        if constexpr (ALIGN_EPI) { if (wr == 0) PG8_BAR; }
        if constexpr (!Epi::AFTER_DRAIN) { E(acc, cur, wr, wc, fr, fq); S.done(cur); }
        if (!has_next) break;
#pragma unroll
        for (int a = 0; a < 2; ++a)
#pragma unroll
            for (int b = 0; b < 2; ++b)
#pragma unroll
                for (int m = 0; m < 4; ++m)
#pragma unroll
                    for (int n = 0; n < 2; ++n) acc[a][b][m][n] = (f32x4){0.f, 0.f, 0.f, 0.f};
        cur = nxt; cA = nA; cB = nB; ++ui;
        if constexpr (ALIGN_EPI) { if (wr == 1) PG8_BAR; }
    }
    PG8_WAIT_V(0);
    if constexpr (!ALIGN_EPI) { if (wr == 0) PG8_BAR; }
    PG8_BAR;
    if constexpr (Epi::AFTER_DRAIN) { E.fused(acc, cur, wr, wc, fr, fq, lds, wid, lane); S.done(cur); }
#undef PG8_SA
#undef PG8_SB
#undef PG8_STAGE
#undef PG8_LDA
#undef PG8_LDB
#undef PG8_MMA
#undef PG8_WAIT_V
#undef PG8_WAIT_L
#undef PG8_BAR
#undef PG8_SCHED
}
}
#define GAS __attribute__((address_space(1)))
#define LAS __attribute__((address_space(3)))
typedef unsigned short bf16;
typedef unsigned v4u __attribute__((ext_vector_type(4)));
typedef float f32x4 __attribute__((ext_vector_type(4)));
typedef short bf16x8 __attribute__((ext_vector_type(8)));
typedef GAS unsigned gu32;
typedef GAS unsigned long long gu64;
#define RLX_AGENT __ATOMIC_RELAXED, __HIP_MEMORY_SCOPE_AGENT
#define LDS_WAIT() asm volatile("s_waitcnt lgkmcnt(0)" ::: "memory")
#define VM_WAIT() asm volatile("s_waitcnt vmcnt(0)" ::: "memory")
__device__ __forceinline__ unsigned long long rt() { return __builtin_amdgcn_s_memrealtime(); }
__device__ __forceinline__ unsigned f2bf(float f) { unsigned u = __builtin_bit_cast(unsigned, f); return (u + 0x7fffu + ((u >> 16) & 1u)) >> 16; }
__device__ __forceinline__ unsigned pk2(float lo, float hi) { return f2bf(lo) | (f2bf(hi) << 16); }

#define XB_TMO      128
#define XB_XCNT(j)  (256  + 64 * (j))
#define XB_XSUB(j)  (1280 + 64 * (j))
#define XB_XGEN(j)  (2304 + 64 * (j))
#define XB_TOP      3328
#define XB_TOPGEN   3392
#define XCD_BAR_WORDS 3456
#define XB_SPIN_CAP (1u << 18)

__device__ __forceinline__ unsigned xb_ld(unsigned* p)              { return __hip_atomic_load(p, __ATOMIC_RELAXED, __HIP_MEMORY_SCOPE_AGENT); }
__device__ __forceinline__ unsigned xb_add(unsigned* p, unsigned v) { return __hip_atomic_fetch_add(p, v, __ATOMIC_RELAXED, __HIP_MEMORY_SCOPE_AGENT); }
__device__ __forceinline__ unsigned xb_xcc_id() { return (unsigned)__builtin_amdgcn_s_getreg((3 << 11) | 20) & 0xFu; }
#define XB_SPIN(cond, bar) do { unsigned _sp = 0; while (cond) { __builtin_amdgcn_s_sleep(1); \
    if ((++_sp & 255u) == 0u) { if (xb_ld(&(bar)[XB_TMO])) break; if (_sp > XB_SPIN_CAP) { atomicAdd(&(bar)[XB_TMO], 1u); break; } } } } while (0)

struct XcdBarrier {
    unsigned* bar; unsigned x;
    volatile LAS unsigned* st;
};

__device__ __forceinline__ XcdBarrier xcd_barrier_post(unsigned* bar, volatile LAS unsigned* st) {
    XcdBarrier b; b.bar = bar; b.x = xb_xcc_id(); b.st = st;
    if (threadIdx.x == 0) (void)xb_add(&bar[XB_XCNT(b.x)], 1u);
    return b;
}
__device__ __forceinline__ void xcd_barrier_complete(unsigned* bar, unsigned x, unsigned& nloc, unsigned& nx) {
    const unsigned G = gridDim.x * gridDim.y * gridDim.z;
    unsigned sum, cnt, mine, sp = 0u;
    for (;;) {
        sum = 0u; cnt = 0u; mine = 0u;
#pragma unroll
        for (unsigned j = 0; j < 16; ++j) { const unsigned c = xb_ld(&bar[XB_XCNT(j)]); sum += c; cnt += (c > 0u) ? 1u : 0u; mine = (j == x) ? c : mine; }
        if (sum == G) break;
        __builtin_amdgcn_s_sleep(1);
        if ((++sp & 255u) == 0u) { if (xb_ld(&bar[XB_TMO])) break; if (sp > XB_SPIN_CAP) { atomicAdd(&bar[XB_TMO], 1u); break; } }
    }
    nloc = mine > 0u ? mine : 1u; nx = cnt > 0u ? cnt : 1u;
}

__device__ __forceinline__ void xcd_barrier(const XcdBarrier& b) {
    asm volatile("s_waitcnt vmcnt(0)" ::: "memory");
    __syncthreads();
    if (threadIdx.x == 0) {
        unsigned* bar = b.bar;
        __builtin_amdgcn_s_waitcnt(0);
        unsigned nloc = b.st[0], nx = b.st[1];
        if (nloc == 0u) { xcd_barrier_complete(bar, b.x, nloc, nx); b.st[0] = nloc; b.st[1] = nx; }
        const unsigned old = xb_add(&bar[XB_XSUB(b.x)], 1u);
        const unsigned gen = old / nloc;
        if (old + 1u == (gen + 1u) * nloc) {
            __builtin_amdgcn_fence(__ATOMIC_RELEASE, "agent");
            asm volatile("s_waitcnt vmcnt(0)" ::: "memory");
            const unsigned og = xb_add(&bar[XB_TOP], 1u);
            const unsigned tg = og / nx;
            if (og + 1u == (tg + 1u) * nx) xb_add(&bar[XB_TOPGEN], 1u);
            else XB_SPIN(xb_ld(&bar[XB_TOPGEN]) == tg, bar);
            __builtin_amdgcn_fence(__ATOMIC_ACQUIRE, "agent");
            xb_add(&bar[XB_XGEN(b.x)], 1u);
            asm volatile("s_waitcnt vmcnt(0)" ::: "memory");
        } else {
            XB_SPIN(xb_ld(&bar[XB_XGEN(b.x)]) == gen, bar);
            __builtin_amdgcn_fence(__ATOMIC_ACQUIRE, "agent");
            asm volatile("s_waitcnt vmcnt(0)" ::: "memory");
        }
    }
    __syncthreads();
}
typedef unsigned u32x4 __attribute__((ext_vector_type(4)));

constexpr int M = 16384, D = 1024, DEPTH = 4, DFF = 2816, NFF = 2 * DFF;
constexpr int A_QKV = 1536, B_QKV = 2304, A_OUT = 1024, B_OUT = 512;
constexpr float C2 = 0.125f * 1.4426950408889634f;
constexpr float LOG2E = 1.4426950408889634f;
constexpr int NWAVES = 8;

constexpr size_t MiB = 1u << 20;
constexpr size_t WS_CTL = 0, CTL_ZERO_BYTES = 1 * MiB;
constexpr size_t WS_MOD = 1 * MiB;
constexpr size_t WS_BIAS = 1 * MiB + 128 * 1024;
constexpr size_t WS_SSQ1 = 1 * MiB + 256 * 1024;
constexpr size_t WS_SSQ2 = 1 * MiB + 512 * 1024;
constexpr size_t WS_BIASP = 2 * MiB;
constexpr size_t WS_LSE = 4 * MiB;
constexpr size_t WS_WB = 8 * MiB;
constexpr size_t WS_XB = 104 * MiB;
constexpr size_t WS_QKV = 136 * MiB;
constexpr size_t WS_O = 208 * MiB;
constexpr size_t WS_OG = 240 * MiB;
constexpr size_t WS_ACT = 288 * MiB;
constexpr size_t WS_END = 376 * MiB;
constexpr int NBIAS = 30208;
constexpr size_t WL_A = (size_t)A_QKV * D + (size_t)D * A_OUT + (size_t)NFF * D + (size_t)D * DFF;
constexpr size_t WL_B = (size_t)B_QKV * D + (size_t)D * B_OUT + (size_t)NFF * D + (size_t)D * DFF;
static_assert(WS_WB + (WL_A + WL_B) * 2 * 2 <= WS_XB, "weight copies fit");
__host__ __device__ __forceinline__ size_t wl_off(int layer) { return (size_t)(layer >> 1) * (WL_A + WL_B) + ((layer & 1) ? WL_A : 0); }
__host__ __device__ __forceinline__ int bias_off(int layer) { return (layer >> 1) * 15104 + ((layer & 1) ? 7168 : 0); }

constexpr int CW_BAR = 4096;
constexpr int RING_OFF = 0, RING_BYTES = 131072;
constexpr int WSF_OFF = RING_BYTES;
constexpr int OST_OFF = WSF_OFF + 2048;
constexpr int LDSCTL_OFF = OST_OFF + 16384, MISC_OFF = LDSCTL_OFF + 320;
constexpr int LDS_BYTES = 151552;
static_assert(MISC_OFF + 128 <= LDS_BYTES, "LDS map");

#ifndef DUP
#define DUP 0
#endif


typedef float f32x16 __attribute__((ext_vector_type(16)));
typedef short s16x4 __attribute__((ext_vector_type(4)));
typedef float f32x2_t __attribute__((ext_vector_type(2))); typedef __bf16 bf16x2_t __attribute__((ext_vector_type(2)));
__device__ __forceinline__ unsigned cvtpk_s(float lo, float hi) { f32x2_t v = {lo, hi}; bf16x2_t b = __builtin_convertvector(v, bf16x2_t); return __builtin_bit_cast(unsigned, b); }
__device__ __forceinline__ int crow(int r, int hi) { return (r & 3) + 8 * (r >> 2) + 4 * hi; }
__device__ __forceinline__ s16x4 vtr(const LAS unsigned char* p) { return __builtin_bit_cast(s16x4, __builtin_amdgcn_ds_read_tr16_b64_v4i16((LAS s16x4*)p)); }
__device__ __forceinline__ float bf2f(unsigned short b) { return __builtin_bit_cast(float, (unsigned)b << 16); }

__device__ __forceinline__ f32x16 alibi_tile(const float dl, const float nslope, const float lo_f, const float hi_f, const int kind) {
    f32x16 b;
    if (kind == 0) {
#pragma unroll
        for (int r = 0; r < 16; ++r) { const float dd = dl + (float)((r & 3) + 8 * (r >> 2)); const bool ok = (dd >= lo_f) && (dd <= hi_f); b[r] = ok ? __builtin_fabsf(dd) * nslope : -INFINITY; }
    } else if (kind == 1) {
#pragma unroll
        for (int r = 0; r < 16; ++r) { const float dd = dl + (float)((r & 3) + 8 * (r >> 2)); b[r] = __builtin_fabsf(dd) * nslope; }
    } else {
        const float sg = (kind == 2) ? -nslope : nslope; const float base = sg * dl;
#pragma unroll
        for (int r = 0; r < 16; ++r) b[r] = __builtin_fmaf(sg, (float)((r & 3) + 8 * (r >> 2)), base);
    }
    return b;
}
__device__ __forceinline__ float half_swap_max(float v) { float a = v, b = v; asm volatile("s_nop 1\n\tv_permlane32_swap_b32 %0, %1\n\ts_nop 1" : "+v"(a), "+v"(b)); return __builtin_fmaxf(a, b); }
__device__ __forceinline__ float half_swap_add(float v) { float a = v, b = v; asm volatile("s_nop 1\n\tv_permlane32_swap_b32 %0, %1\n\ts_nop 1" : "+v"(a), "+v"(b)); return a + b; }
#define ATT_SB() __builtin_amdgcn_sched_barrier(0)
template <int HW, int NQT, bool SINK, int THR>
__device__ __forceinline__ void attn_unit(LAS unsigned char* lds, const bf16* __restrict__ qkv, const int pitch, const int c, const int d, const int U0, const int Ls,
                                          const int qcol0, const int kcol, const int vcol, const int hflat0, const float slope_den, const float* __restrict__ sink,
                                          bf16* __restrict__ O, const int opitch, const int ocol0, float* __restrict__ lse, const int lse_slot0) {
    constexpr int NKEYS = 32 * NQT + 2 * HW, NSLOT = NKEYS / 64, NKT = 1 + 2 * HW / 32, GPW = NQT / 2, MID = HW / 32;
    constexpr int K_OFF = 0, V_OFF = NSLOT * 8192;
    static_assert(2 * NSLOT * 8192 <= RING_BYTES, "K/V fit the ring region");
    int tid_ = threadIdx.x; asm volatile("" : "+v"(tid_));
    const int tid = tid_, lane = tid & 63, r32 = lane & 31, hi = lane >> 5; const int wid = __builtin_amdgcn_readfirstlane(tid >> 6);
    for (int rep_ = 0; rep_ < ((DUP == 24 && HW == 128) ? 2 : 1); ++rep_) {
    if (rep_) { asm volatile("s_waitcnt vmcnt(0)" ::: "memory"); __syncthreads(); }
#pragma unroll
    for (int s = 0; s < NSLOT; ++s) {
        { int idx = U0 - HW + 64 * s + lane; idx = idx < 0 ? 0 : (idx > Ls - 1 ? Ls - 1 : idx); const size_t tok = (size_t)c + (size_t)d * idx;
          const bf16* src = qkv + tok * pitch + kcol + 8 * wid;
          __builtin_amdgcn_global_load_lds((const unsigned*)src, (LAS unsigned*)(lds + K_OFF + s * 8192 + wid * 1024), 16, 0, 0); }
        { int idx = U0 - HW + 64 * s + 16 * (wid & 3) + (lane >> 2); idx = idx < 0 ? 0 : (idx > Ls - 1 ? Ls - 1 : idx); const size_t tok = (size_t)c + (size_t)d * idx;
          const bf16* src = qkv + tok * pitch + vcol + 32 * (wid >> 2) + 8 * (lane & 3);
          __builtin_amdgcn_global_load_lds((const unsigned*)src, (LAS unsigned*)(lds + V_OFF + s * 8192 + wid * 1024), 16, 0, 0); }
    }
    }
    const int qt = wid % NQT, gbase = (wid / NQT) * GPW;
    const int uq = U0 + 32 * qt + r32;
    const size_t qtok = (size_t)c + (size_t)d * uq;
    const bf16* qp0 = qkv + qtok * pitch + qcol0 + 8 * hi;
    bf16x8 qr[4];
#pragma unroll
    for (int d0 = 0; d0 < 4; ++d0) qr[d0] = *(const bf16x8*)(qp0 + 64 * gbase + 16 * d0);
    asm volatile("s_waitcnt vmcnt(0)" ::: "memory");
    __syncthreads();
    LAS float* wsf = (LAS float*)(lds + WSF_OFF) + wid * 64;
    LAS bf16* stg = (LAS bf16*)(lds + OST_OFF) + wid * 1024;
    const bool edge = (U0 < HW) || (U0 + 32 * NQT + HW > Ls);
    const float lo_f = (float)((-uq) > -HW ? (-uq) : -HW), hi_f = (float)((Ls - 1 - uq) < HW ? (Ls - 1 - uq) : HW);
    const int vlane = ((lane >> 4) & 1) * 32 + (lane & 3) * 8 + (4 * hi + ((lane & 15) >> 2)) * 64;
    const LAS unsigned char* kbase = lds + K_OFF + hi * 1024 + r32 * 16;
    const float dl0 = (float)(4 * hi - HW - r32);
    const size_t tok0 = (size_t)c + (size_t)d * (size_t)(U0 + 32 * qt);
    for (int gg_ = 0; gg_ < ((DUP == 25 && HW == 128) ? 2 * GPW : GPW); ++gg_) {
        const int gg = gg_ % GPW; const int g = gbase + gg;
        const float slope = __builtin_amdgcn_exp2f(-8.0f * (float)(hflat0 + g + 1) / slope_den);
        const float nslope = -slope * LOG2E * (float)d;
        bf16x8 qn[4];
#pragma unroll
        for (int d0 = 0; d0 < 4; ++d0) qn[d0] = qr[d0];
        if (gg + 1 < GPW || DUP == 25) {
#pragma unroll
            for (int d0 = 0; d0 < 4; ++d0) qn[d0] = *(const bf16x8*)(qp0 + 64 * (gbase + (gg + 1) % GPW) + 16 * d0);
        }
        float m, l; f32x16 o0, o1;
        for (int rep2_ = 0; rep2_ < ((DUP == 26 && HW == 128) ? 2 : 1); ++rep2_) {
        m = SINK ? sink[g] * LOG2E : -1e30f;
        l = (SINK && hi == 0) ? 1.0f : 0.0f;
        o0 = f32x16{}; o1 = f32x16{};
        f32x16 p = alibi_tile(dl0, nslope, lo_f, hi_f, 0);
        {   const LAS unsigned char* kb = kbase + (qt >> 1) * 8192 + (qt & 1) * 512;
            const bf16x8 k0 = *(const LAS bf16x8*)(kb), k1 = *(const LAS bf16x8*)(kb + 2048), k2 = *(const LAS bf16x8*)(kb + 4096), k3 = *(const LAS bf16x8*)(kb + 6144);
            p = __builtin_amdgcn_mfma_f32_32x32x16_bf16(k0, qr[0], p, 0, 0, 0); p = __builtin_amdgcn_mfma_f32_32x32x16_bf16(k1, qr[1], p, 0, 0, 0);
            p = __builtin_amdgcn_mfma_f32_32x32x16_bf16(k2, qr[2], p, 0, 0, 0); p = __builtin_amdgcn_mfma_f32_32x32x16_bf16(k3, qr[3], p, 0, 0, 0); }
#pragma unroll 1
        for (int jj = 0; jj < NKT; ++jj) {
            const int j = qt + jj, slot = j >> 1, half = j & 1;
            const bool more = jj + 1 < NKT;
            const int j1 = more ? j + 1 : j;
            const LAS unsigned char* kb = kbase + (j1 >> 1) * 8192 + (j1 & 1) * 512;
            const bf16x8 k0 = *(const LAS bf16x8*)(kb), k1 = *(const LAS bf16x8*)(kb + 2048), k2 = *(const LAS bf16x8*)(kb + 4096), k3 = *(const LAS bf16x8*)(kb + 6144);
            const LAS unsigned char* vb = lds + V_OFF + slot * 8192 + (2 * half) * 1024 + vlane;
            const s16x4 a0 = vtr(vb), a1 = vtr(vb + 512), b0 = vtr(vb + 1024), b1 = vtr(vb + 1024 + 512);
            const s16x4 c0 = vtr(vb + 4096), c1 = vtr(vb + 4096 + 512), e0 = vtr(vb + 4096 + 1024), e1 = vtr(vb + 4096 + 1024 + 512);
            ATT_SB();
            const int kind = (edge || jj + 1 >= NKT - 1) ? 0 : (jj + 1 == MID ? 1 : (jj + 1 < MID ? 2 : 3));
            f32x16 pn = alibi_tile(dl0 + 32.0f * (float)(jj + 1), nslope, lo_f, hi_f, kind);
            ATT_SB();
            if (more) { pn = __builtin_amdgcn_mfma_f32_32x32x16_bf16(k0, qr[0], pn, 0, 0, 0); pn = __builtin_amdgcn_mfma_f32_32x32x16_bf16(k1, qr[1], pn, 0, 0, 0);
                        pn = __builtin_amdgcn_mfma_f32_32x32x16_bf16(k2, qr[2], pn, 0, 0, 0); pn = __builtin_amdgcn_mfma_f32_32x32x16_bf16(k3, qr[3], pn, 0, 0, 0); }
            ATT_SB();
            float rm = __builtin_fmaxf(p[0], p[1]);
#pragma unroll
            for (int r = 2; r < 16; ++r) rm = __builtin_fmaxf(rm, p[r]);
            rm = half_swap_max(rm);
            if (__any(rm > m + (float)THR)) {
                const float mn = __builtin_fmaxf(m, rm); const float alpha = __builtin_amdgcn_exp2f(m - mn);
                l *= alpha; m = mn;
                if (hi == 0) wsf[r32] = alpha;
                asm volatile("s_waitcnt lgkmcnt(0)" ::: "memory");
#pragma unroll
                for (int r = 0; r < 16; ++r) { const float a = wsf[crow(r, hi)]; o0[r] *= a; o1[r] *= a; }
            }
            float ls = 0.f;
#pragma unroll
            for (int r = 0; r < 16; ++r) { p[r] = __builtin_amdgcn_exp2f(p[r] - m); ls += p[r]; }
            l += ls;
            u32x4 pw0, pw1;
            pw0[0] = cvtpk_s(p[0], p[1]); pw0[1] = cvtpk_s(p[2], p[3]); pw0[2] = cvtpk_s(p[4], p[5]); pw0[3] = cvtpk_s(p[6], p[7]);
            pw1[0] = cvtpk_s(p[8], p[9]); pw1[1] = cvtpk_s(p[10], p[11]); pw1[2] = cvtpk_s(p[12], p[13]); pw1[3] = cvtpk_s(p[14], p[15]);
            const bf16x8 pa0 = __builtin_bit_cast(bf16x8, pw0), pa1 = __builtin_bit_cast(bf16x8, pw1);
            ATT_SB();
            o0 = __builtin_amdgcn_mfma_f32_32x32x16_bf16(pa0, (bf16x8){a0[0], a0[1], a0[2], a0[3], a1[0], a1[1], a1[2], a1[3]}, o0, 0, 0, 0);
            o1 = __builtin_amdgcn_mfma_f32_32x32x16_bf16(pa0, (bf16x8){c0[0], c0[1], c0[2], c0[3], c1[0], c1[1], c1[2], c1[3]}, o1, 0, 0, 0);
            o0 = __builtin_amdgcn_mfma_f32_32x32x16_bf16(pa1, (bf16x8){b0[0], b0[1], b0[2], b0[3], b1[0], b1[1], b1[2], b1[3]}, o0, 0, 0, 0);
            o1 = __builtin_amdgcn_mfma_f32_32x32x16_bf16(pa1, (bf16x8){e0[0], e0[1], e0[2], e0[3], e1[0], e1[1], e1[2], e1[3]}, o1, 0, 0, 0);
            p = pn;
        }
        }
        const float lt = half_swap_add(l);
        if (hi == 0) { wsf[32 + r32] = __builtin_amdgcn_rcpf(lt); if (lse) lse[qtok * 8 + lse_slot0 + g] = m + __builtin_amdgcn_logf(lt); }
        asm volatile("s_waitcnt lgkmcnt(0)" ::: "memory");
        float rl[16];
#pragma unroll
        for (int r = 0; r < 16; ++r) rl[r] = wsf[32 + crow(r, hi)];
#pragma unroll
        for (int dh = 0; dh < 2; ++dh) {
#pragma unroll
            for (int r = 0; r < 16; ++r) stg[crow(r, hi) * 32 + r32] = (bf16)(cvtpk_s((dh ? o1[r] : o0[r]) * rl[r], 0.f) & 0xffffu);
            asm volatile("s_waitcnt lgkmcnt(0)" ::: "memory");
#pragma unroll
            for (int ps = 0; ps < 2; ++ps) { const int row = ps * 16 + (lane >> 2), ch = lane & 3; const u32x4 v = *(const LAS u32x4*)(stg + row * 32 + ch * 8);
                *(u32x4*)(O + (tok0 + (size_t)d * row) * opitch + ocol0 + 64 * g + 32 * dh + 8 * ch) = v; }
            asm volatile("s_waitcnt lgkmcnt(0)" ::: "memory");
        }
#pragma unroll
        for (int d0 = 0; d0 < 4; ++d0) qr[d0] = qn[d0];
    }
    __syncthreads();
}

struct Frame {
    LAS unsigned char* lds; volatile LAS unsigned* MISC; gu32* ctl;
    int tid, lane, wave, vcu, G;
    const float *x, *cvec, *ada_w, *ada_b, *norm_mix, *norm_ffn, *ffn_w_in, *ffn_w_out, *a_w_in, *a_w_out, *a_sink, *b_w_in, *b_w_out, *final_norm;
    float* out; unsigned char* ws;
    float *mod, *bias, *ssq1, *ssq2, *biasp, *lse; bf16 *wb, *xb, *qkv, *o, *og, *act;
};
__device__ __forceinline__ float wave_sum(float v) {
#pragma unroll
    for (int o = 1; o < 64; o <<= 1) v += __shfl_xor(v, o);
    return v;
}

__device__ __forceinline__ void p0_mod_and_x(Frame& F) {
    LAS float* condl = (LAS float*)(F.lds + RING_OFF);
    for (int k = F.tid; k < D; k += NWAVES * 64) { const float cv = F.cvec[k]; condl[k] = cv / (1.0f + __expf(-cv)); }
    __syncthreads();
    const int NGW = F.G * NWAVES;
    for (int it = F.wave * F.G + F.vcu; it < DEPTH * 192; it += NGW) {
        const int layer = it / 192, n0 = 32 * (it % 192), kq = F.lane >> 3, c4 = F.lane & 7;
        const float* W = F.ada_w + (size_t)layer * D * 6 * D + n0 + 4 * c4;
        f32x4 acc = {0.f, 0.f, 0.f, 0.f};
#pragma unroll 8
        for (int i = 0; i < 128; ++i) { const int k = kq + 8 * i; const f32x4 w = *(const f32x4*)(W + (size_t)k * 6 * D); acc += w * condl[k]; }
#pragma unroll
        for (int o = 8; o < 64; o <<= 1) { acc.x += __shfl_xor(acc.x, o); acc.y += __shfl_xor(acc.y, o); acc.z += __shfl_xor(acc.z, o); acc.w += __shfl_xor(acc.w, o); }
        if (F.lane < 8) { const f32x4 b = *(const f32x4*)(F.ada_b + (size_t)layer * 6 * D + n0 + 4 * c4); *(f32x4*)(F.mod + (size_t)layer * 6 * D + n0 + 4 * c4) = acc + b; }
    }
    const int gw = F.vcu * NWAVES + F.wave;
    for (int m = gw; m < M; m += NGW) {
        const f32x4* xr = (const f32x4*)(F.x + (size_t)m * D) + F.lane;
        f32x4 v[4]; float s = 0.f;
#pragma unroll
        for (int j = 0; j < 4; ++j) { v[j] = xr[64 * j]; s += (v[j].x * v[j].x + v[j].y * v[j].y) + (v[j].z * v[j].z + v[j].w * v[j].w); }
        s = wave_sum(s);
        if (F.lane < 4) F.ssq1[(size_t)m * 4 + F.lane] = (F.lane == 0) ? s : 0.f;
        unsigned long long* o8 = (unsigned long long*)(F.xb + (size_t)m * D) + F.lane;
#pragma unroll
        for (int j = 0; j < 4; ++j) o8[64 * j] = (unsigned long long)cvtpk_s(v[j].x, v[j].y) | ((unsigned long long)cvtpk_s(v[j].z, v[j].w) << 32);
    }
}

__device__ __forceinline__ void prep_item(const float* __restrict__ W, const int K, const int N, const int k0, const int n0, bf16* __restrict__ WT, const int dest0,
                                          const float* __restrict__ nrm, const float* __restrict__ sc, const float* __restrict__ colmod, const float colconst,
                                          const float* __restrict__ sh, float* __restrict__ biasp_dst, LAS float* scr, const int lane) {
    {   float wv[32]; const float* wp = W + (size_t)(k0 + (lane >> 5)) * N + n0 + (lane & 31);
#pragma unroll
        for (int i = 0; i < 32; ++i) wv[i] = wp[(size_t)(2 * i) * N];
#pragma unroll
        for (int i = 0; i < 32; ++i) scr[(2 * i + (lane >> 5)) * 33 + (lane & 31)] = wv[i]; }
    asm volatile("s_waitcnt lgkmcnt(0)" ::: "memory");
    if (sh) {
        const int col = lane & 31, hb = (lane >> 5) * 32; float s = 0.f;
#pragma unroll 8
        for (int kk = 0; kk < 32; ++kk) s += sh[k0 + hb + kk] * scr[(hb + kk) * 33 + col];
        s += __shfl_xor(s, 32);
        if (lane < 32) biasp_dst[col] = s * colconst;
    }
    const int cch = lane & 7;
    float rsv[8];
#pragma unroll
    for (int e = 0; e < 8; ++e) { const int k = k0 + 8 * cch + e; rsv[e] = nrm ? nrm[k] * (1.0f + sc[k]) : 1.0f; }
#pragma unroll
    for (int j = 0; j < 4; ++j) { const int n = (lane >> 3) + 8 * j; const float cs = colconst * (colmod ? colmod[n0 + n] : 1.0f);
        const LAS float* s = scr + (8 * cch) * 33 + n;
        v4u o; o.x = cvtpk_s(s[0 * 33] * rsv[0] * cs, s[1 * 33] * rsv[1] * cs); o.y = cvtpk_s(s[2 * 33] * rsv[2] * cs, s[3 * 33] * rsv[3] * cs);
        o.z = cvtpk_s(s[4 * 33] * rsv[4] * cs, s[5 * 33] * rsv[5] * cs); o.w = cvtpk_s(s[6 * 33] * rsv[6] * cs, s[7 * 33] * rsv[7] * cs);
        *(v4u*)(WT + (size_t)(dest0 + n) * K + k0 + 8 * cch) = o; }
    asm volatile("s_waitcnt lgkmcnt(0)" ::: "memory");
}
constexpr int PREP_IA = 768 + 512 + 2816 + 1408, PREP_IB = 1152 + 256 + 2816 + 1408;
__device__ __forceinline__ void prep_range(Frame& F, const int layer, const int it_lo, const int it_hi, const int widx, const int nw, const int wave, const int lane) {
    LAS float* scr = (LAS float*)(F.lds + RING_OFF + wave * 16384);
    const int t = layer & 1, jl = layer >> 1;
    for (int it = it_lo + widx; it < it_hi; it += nw) {
        int r = it;
        const float* mod = F.mod + (size_t)layer * 6 * D;
        const int n1 = t ? B_QKV : A_QKV, k2 = t ? B_OUT : A_OUT, dq = t ? 1536 : 1024;
        bf16* wl = F.wb + wl_off(layer);
        const int I1 = (n1 / 32) * 16, I2 = 32 * (k2 / 64), I3 = (NFF / 32) * 16;
        if (r < I1) {
            const int nblk = n1 / 32, nb = r % nblk, kb = r / nblk, n0 = 32 * nb;
            const float* W = t ? F.b_w_in + (size_t)jl * D * B_QKV : F.a_w_in + (size_t)jl * D * A_QKV;
            prep_item(W, D, n1, 64 * kb, n0, wl, n0, F.norm_mix + layer * D, mod + D, nullptr, n0 < dq ? C2 : 1.0f, mod, F.biasp + (size_t)kb * NBIAS + bias_off(layer) + n0, scr, lane);
            continue; }
        r -= I1;
        if (r < I2) {
            const int nb = r % 32, kb = r / 32, n0 = 32 * nb;
            const float* W = t ? F.b_w_out + (size_t)jl * B_OUT * D : F.a_w_out + (size_t)jl * A_OUT * D;
            prep_item(W, k2, D, 64 * kb, n0, wl + (size_t)n1 * D, n0, nullptr, nullptr, mod + 2 * D, 1.0f, nullptr, nullptr, scr, lane);
            continue; }
        r -= I2;
        if (r < I3) {
            const int nblk = NFF / 32, nb = r % nblk, kb = r / nblk, n0 = 32 * nb;
            const int dest0 = n0 < DFF ? 256 * (n0 / 128) + (n0 % 128) : 256 * ((n0 - DFF) / 128) + 128 + ((n0 - DFF) % 128);
            prep_item(F.ffn_w_in + (size_t)layer * D * NFF, D, NFF, 64 * kb, n0, wl + (size_t)n1 * D + (size_t)D * k2, dest0, F.norm_ffn + layer * D, mod + 4 * D, nullptr, 1.0f, mod + 3 * D,
                      F.biasp + (size_t)kb * NBIAS + bias_off(layer) + n1 + dest0, scr, lane);
            continue; }
        r -= I3;
        {
            const int nb = r % 32, kb = r / 32, n0 = 32 * nb;
            prep_item(F.ffn_w_out + (size_t)layer * DFF * D, DFF, D, 64 * kb, n0, wl + (size_t)n1 * D + (size_t)D * k2 + (size_t)NFF * D, n0, nullptr, nullptr, mod + 5 * D, 1.0f, nullptr, nullptr, scr, lane);
        }
    }
}
__device__ __forceinline__ void bias_reduce(Frame& F, const int layer) {
    int tid_ = threadIdx.x; asm volatile("" : "+v"(tid_));
    const int idx = blockIdx.x * (NWAVES * 64) + tid_, n = ((layer & 1) ? B_QKV : A_QKV) + NFF, off = bias_off(layer);
    for (int i = idx; i < n; i += F.G * NWAVES * 64) { float s = 0.f;
#pragma unroll
        for (int kb = 0; kb < 16; ++kb) s += F.biasp[(size_t)kb * NBIAS + off + i];
        F.bias[off + i] = s; }
}
__device__ __forceinline__ void tail_prep(Frame& F, const int layer_next, const int nunits, const int part) {
    const int rem = nunits % F.G; if (rem == 0) return;
    const int c = (int)blockIdx.x; if (c < rem) return;
    const int prev_t = (layer_next - 1) & 1;
    const int ns1 = F.G - ((prev_t ? (M / 256) * (B_QKV / 256) : (M / 256) * (A_QKV / 256)) % F.G), ns3 = F.G - (((M / 256) * (NFF / 256)) % F.G);
    const int IL = (layer_next & 1) ? PREP_IB : PREP_IA;
    const int cut = (int)((long)IL * ns1 / (ns1 + ns3));
    int tid_ = threadIdx.x; asm volatile("" : "+v"(tid_)); const int wave = __builtin_amdgcn_readfirstlane(tid_ >> 6), lane = tid_ & 63;
    prep_range(F, layer_next, part == 0 ? 0 : cut, part == 0 ? cut : IL, (c - rem) * NWAVES + wave, (F.G - rem) * NWAVES, wave, lane);
}
__device__ __forceinline__ void merge_groups(Frame& F) {
    const int gw = F.vcu * NWAVES + F.wave, NGW = F.G * NWAVES;
    for (int m = gw; m < M; m += NGW) {
        const int slot = F.lane >> 3;
        const float l0 = F.lse[(size_t)m * 8 + slot], l1 = F.lse[(size_t)M * 8 + (size_t)m * 8 + slot], l2 = F.lse[(size_t)2 * M * 8 + (size_t)m * 8 + slot];
        const float mx = __builtin_fmaxf(__builtin_fmaxf(l0, l1), l2);
        float w0 = __builtin_amdgcn_exp2f(l0 - mx), w1 = __builtin_amdgcn_exp2f(l1 - mx), w2 = __builtin_amdgcn_exp2f(l2 - mx);
        const float inv = __builtin_amdgcn_rcpf(w0 + w1 + w2); w0 *= inv; w1 *= inv; w2 *= inv;
        const v4u a = *(const v4u*)(F.og + (size_t)m * 512 + 8 * F.lane), b = *(const v4u*)(F.og + (size_t)M * 512 + (size_t)m * 512 + 8 * F.lane), cc = *(const v4u*)(F.og + (size_t)2 * M * 512 + (size_t)m * 512 + 8 * F.lane);
        v4u o;
#pragma unroll
        for (int e = 0; e < 4; ++e) {
            const float lo = w0 * __builtin_bit_cast(float, a[e] << 16) + w1 * __builtin_bit_cast(float, b[e] << 16) + w2 * __builtin_bit_cast(float, cc[e] << 16);
            const float hi = w0 * __builtin_bit_cast(float, a[e] & 0xffff0000u) + w1 * __builtin_bit_cast(float, b[e] & 0xffff0000u) + w2 * __builtin_bit_cast(float, cc[e] & 0xffff0000u);
            o[e] = cvtpk_s(lo, hi); }
        *(v4u*)(F.o + (size_t)m * 512 + 8 * F.lane) = o;
    }
}
__device__ __forceinline__ void final_norm(Frame& F) {
    const int gw = F.vcu * NWAVES + F.wave, NGW = F.G * NWAVES;
    for (int m = gw; m < M; m += NGW) {
        const float rs = pg8::row_rstd(F.ssq1, m);
        f32x4* xr = (f32x4*)(F.out + (size_t)m * D) + F.lane; const f32x4* fw = (const f32x4*)F.final_norm + F.lane;
#pragma unroll
        for (int j = 0; j < 4; ++j) { const f32x4 v = xr[64 * j]; xr[64 * j] = v * rs * fw[64 * j]; }
    }
}

#ifndef MK_MULTI
#define MK_MULTI 0
#endif
#ifndef TAILPREP
#define TAILPREP 1
#endif
#ifndef ATT_THR
#define ATT_THR 6
#endif
constexpr int NPHASES = 3 + 6 * DEPTH + 1;
struct Args { const float* in[14]; float* out; unsigned char* ws; int ph_lo, ph_hi; };
__global__ void __launch_bounds__(NWAVES * 64, 2) fwd_kernel(Args args) {
    extern __shared__ __attribute__((aligned(16))) unsigned char lds_raw[];
    Frame F;
    F.lds = (LAS unsigned char*)lds_raw; F.MISC = (volatile LAS unsigned*)(F.lds + MISC_OFF);
    F.tid = threadIdx.x; F.lane = F.tid & 63; F.wave = __builtin_amdgcn_readfirstlane(F.tid >> 6);
    F.G = gridDim.x; { const int bx = blockIdx.x; F.vcu = (F.G % 8 == 0) ? (bx % 8) * (F.G / 8) + bx / 8 : bx; }
    unsigned char* ws = args.ws; F.ws = ws; F.ctl = (gu32*)(ws + WS_CTL);
    F.x = args.in[0]; F.cvec = args.in[1]; F.ada_w = args.in[2]; F.ada_b = args.in[3]; F.norm_mix = args.in[4]; F.norm_ffn = args.in[5]; F.ffn_w_in = args.in[6]; F.ffn_w_out = args.in[7];
    F.a_w_in = args.in[8]; F.a_w_out = args.in[9]; F.a_sink = args.in[10]; F.b_w_in = args.in[11]; F.b_w_out = args.in[12]; F.final_norm = args.in[13]; F.out = args.out;
    F.mod = (float*)(ws + WS_MOD); F.bias = (float*)(ws + WS_BIAS); F.ssq1 = (float*)(ws + WS_SSQ1); F.ssq2 = (float*)(ws + WS_SSQ2); F.biasp = (float*)(ws + WS_BIASP); F.lse = (float*)(ws + WS_LSE);
    F.wb = (bf16*)(ws + WS_WB); F.xb = (bf16*)(ws + WS_XB); F.qkv = (bf16*)(ws + WS_QKV); F.o = (bf16*)(ws + WS_O); F.og = (bf16*)(ws + WS_OG); F.act = (bf16*)(ws + WS_ACT);
    for (int u = F.tid; u < (LDS_BYTES - LDSCTL_OFF) / 4; u += NWAVES * 64) ((LAS unsigned*)(F.lds + LDSCTL_OFF))[u] = 0u;
    __syncthreads();
    const int lo = args.ph_lo, hi = args.ph_hi;
    XcdBarrier bar; bar.bar = (unsigned*)(F.ctl + CW_BAR); bar.x = 0; bar.st = nullptr;
    if (hi - lo > 1) bar = xcd_barrier_post((unsigned*)(F.ctl + CW_BAR), F.MISC + 8);
#define RUN(p) (lo <= (p) && (p) < hi)
#define SEAM(p) do { if (RUN(p) && RUN((p) + 1)) { xcd_barrier(bar); if (DUP == 7) xcd_barrier(bar); } } while (0)

    for (int rep = 0; rep < (DUP == 6 ? 2 : 1); ++rep) {
    if (RUN(0)) { p0_mod_and_x(F); } SEAM(0);
    if (RUN(1)) { for (int ly = 0; ly < (TAILPREP ? 1 : DEPTH); ++ly) prep_range(F, ly, 0, (ly & 1) ? PREP_IB : PREP_IA, F.vcu * NWAVES + F.wave, F.G * NWAVES, F.wave, F.lane); } SEAM(1);
    if (RUN(2)) { for (int ly = 0; ly < (TAILPREP ? 1 : DEPTH); ++ly) bias_reduce(F, ly); } SEAM(2);
    }

    for (int layer = 0; layer < DEPTH; ++layer) {
        const int pb = 3 + 6 * layer, t = layer & 1, jl = layer >> 1;
        const int n1 = t ? B_QKV : A_QKV, k2 = t ? B_OUT : A_OUT;
        const bf16* wl = F.wb + wl_off(layer);
        const float* bias1 = F.bias + bias_off(layer);
        for (int rep = 0; rep < (DUP == 1 ? 2 : 1); ++rep) {
        if (RUN(pb)) {
            pg8::Gemm g{F.xb, wl, M, n1, D}; pg8::StaticOrder S; S.init(M, n1, F.G, (int)blockIdx.x);
            pg8::EpiQKV E{F.qkv, n1, bias1, F.ssq1};
            pg8::gemm_phase<pg8::EpiQKV, pg8::StaticOrder, true, true>(F.lds + RING_OFF, g, S, E);
            if (TAILPREP && layer + 1 < DEPTH) tail_prep(F, layer + 1, (M / 256) * (n1 / 256), 0);
        }
        SEAM(pb);
        }
        for (int rep = 0; rep < ((DUP == 2 || (DUP == 21 && t == 0) || (DUP == 22 && t == 1)) ? 2 : 1); ++rep) {
        if (RUN(pb + 1)) {
            if (t == 0) {
                for (int u = F.vcu; u < 256; u += F.G) { const int qb = u >> 2, hkv = u & 3;
                    attn_unit<128, 8, true, ATT_THR>(F.lds + RING_OFF, F.qkv, A_QKV, 0, 1, 256 * qb, M, 256 * hkv, 1024 + 64 * hkv, 1280 + 64 * hkv, 4 * hkv, 16.0f, F.a_sink + jl * 16 + 4 * hkv,
                                                   F.o, 1024, 256 * hkv, nullptr, 0); }
            } else {
                for (int u = F.vcu; u < 768; u += F.G) { const int gi = u >> 8, rem = u & 255, hkv = rem & 1, cb = rem >> 1; const int dd = 1 << (2 * gi), cc = cb & (dd - 1), blk = cb >> (2 * gi);
                    attn_unit<64, 4, false, ATT_THR>(F.lds + RING_OFF, F.qkv, B_QKV, cc, dd, 128 * blk, M >> (2 * gi), (gi * 8 + hkv * 4) * 64, 1536 + (gi * 2 + hkv) * 64, 1920 + (gi * 2 + hkv) * 64,
                                                   gi * 8 + hkv * 4, 24.0f, nullptr, F.og + (size_t)gi * M * 512, 512, 256 * hkv, F.lse + (size_t)gi * M * 8, 4 * hkv); }
            }
        }
        SEAM(pb + 1);
        if (RUN(pb + 2)) { if (t == 1) { merge_groups(F); if (DUP == 23) { xcd_barrier(bar); merge_groups(F); } } }
        if (t == 1) SEAM(pb + 2);
        }
        if (RUN(pb + 3)) {
            pg8::Gemm g{F.o, wl + (size_t)n1 * D, M, D, k2}; pg8::StaticOrder S; S.init(M, D, F.G, (int)blockIdx.x);
            if (DUP == 3) { pg8::EpiResid E2{layer == 0 ? F.x : F.out, (float*)F.act, F.qkv, F.lse}; pg8::gemm_phase<pg8::EpiResid, pg8::StaticOrder, false, true>(F.lds + RING_OFF, g, S, E2); xcd_barrier(bar); }
            pg8::EpiResid E{layer == 0 ? F.x : F.out, F.out, F.xb, F.ssq2};
            pg8::gemm_phase<pg8::EpiResid, pg8::StaticOrder, false, true>(F.lds + RING_OFF, g, S, E);
        }
        SEAM(pb + 3);
        for (int rep = 0; rep < (DUP == 4 ? 2 : 1); ++rep) {
        if (RUN(pb + 4)) {
            pg8::Gemm g{F.xb, wl + (size_t)n1 * D + (size_t)D * k2, M, NFF, D}; pg8::StaticOrder S; S.init(M, NFF, F.G, (int)blockIdx.x);
            pg8::EpiSwiGLU E{F.act, DFF, bias1 + n1, F.ssq2};
            if (DUP == 41) { pg8::EpiNull EN; pg8::gemm_phase<pg8::EpiNull, pg8::StaticOrder, true, true>(F.lds + RING_OFF, g, S, EN); xcd_barrier(bar); }
            pg8::gemm_phase<pg8::EpiSwiGLU, pg8::StaticOrder, true, true>(F.lds + RING_OFF, g, S, E);
            if (TAILPREP && layer + 1 < DEPTH) tail_prep(F, layer + 1, (M / 256) * (NFF / 256), 1);
        }
        SEAM(pb + 4);
        }
        if (RUN(pb + 5)) {
            if (TAILPREP && layer + 1 < DEPTH) bias_reduce(F, layer + 1);
            pg8::Gemm g{F.act, wl + (size_t)n1 * D + (size_t)D * k2 + (size_t)NFF * D, M, D, DFF}; pg8::StaticOrder S; S.init(M, D, F.G, (int)blockIdx.x);
            if (DUP == 51) { pg8::EpiNull EN; pg8::gemm_phase<pg8::EpiNull, pg8::StaticOrder, true, true>(F.lds + RING_OFF, g, S, EN); xcd_barrier(bar); }
            if (DUP == 5) { pg8::EpiResid E2{F.out, (float*)F.qkv, F.o, F.lse}; pg8::gemm_phase<pg8::EpiResid, pg8::StaticOrder, false, true>(F.lds + RING_OFF, g, S, E2); xcd_barrier(bar); }
            pg8::EpiResid E{F.out, F.out, F.xb, F.ssq1};
            pg8::gemm_phase<pg8::EpiResid, pg8::StaticOrder, false, true>(F.lds + RING_OFF, g, S, E);
        }
        SEAM(pb + 5);
    }
    if (RUN(NPHASES - 1)) final_norm(F);
#undef RUN
#undef SEAM
}

extern "C" void kernel_launch(void* const* d_in, const int* in_sizes, int n_in, void* d_out, int out_size, void* d_ws, size_t ws_size, hipStream_t stream) {
    static int grid = 0;
    if (grid == 0) {
        if (n_in != 14 || in_sizes[0] != M * D || out_size != M * D || ws_size < WS_END) { fprintf(stderr, "kernel_launch: unexpected shapes / workspace (n_in %d, in0 %d, out %d, ws %zu)\n", n_in, n_in > 0 ? in_sizes[0] : -1, out_size, ws_size); grid = -1; return; }
        int dev = 0, cus = 0, per_cu = 0;
        if (hipGetDevice(&dev) != hipSuccess || hipDeviceGetAttribute(&cus, hipDeviceAttributeMultiprocessorCount, dev) != hipSuccess) { grid = -1; return; }
        if (hipFuncSetAttribute((const void*)fwd_kernel, hipFuncAttributeMaxDynamicSharedMemorySize, LDS_BYTES) != hipSuccess) { fprintf(stderr, "kernel_launch: hipFuncSetAttribute failed\n"); grid = -1; return; }
        if (hipOccupancyMaxActiveBlocksPerMultiprocessor(&per_cu, (const void*)fwd_kernel, NWAVES * 64, LDS_BYTES) != hipSuccess || per_cu < 1) fprintf(stderr, "kernel_launch: occupancy query reports %d blocks per CU\n", per_cu);
        (void)hipGetLastError();
        grid = cus;
        if (grid != 256) fprintf(stderr, "kernel_launch: %d CUs (built for 256)\n", grid);
    }
    if (grid < 0) return;
    (void)hipMemsetAsync((char*)d_ws + WS_CTL, 0, CTL_ZERO_BYTES, stream);
    Args a{};
    for (int i = 0; i < 14; ++i) a.in[i] = (const float*)d_in[i];
    a.out = (float*)d_out; a.ws = (unsigned char*)d_ws;
#if MK_MULTI
    for (int p = 0; p < NPHASES; ++p) {
        if (p >= 3 && p < NPHASES - 1 && ((p - 3) % 6) == 2 && (((p - 3) / 6) & 1) == 0) continue;
        a.ph_lo = p; a.ph_hi = p + 1;
        hipLaunchKernelGGL(fwd_kernel, dim3(grid), dim3(NWAVES * 64), LDS_BYTES, stream, a);
    }
#else
    a.ph_lo = 0; a.ph_hi = NPHASES;
    hipLaunchKernelGGL(fwd_kernel, dim3(grid), dim3(NWAVES * 64), LDS_BYTES, stream, a);
#endif
}
```

```cpp
#include <hip/hip_runtime.h>
#include <cstdio>
#include <cstdint>
namespace pg8 {
#define PG8_LAS __attribute__((address_space(3)))
typedef unsigned short bf16_t;
typedef short bf16x8 __attribute__((ext_vector_type(8)));
typedef float f32x4 __attribute__((ext_vector_type(4)));
typedef unsigned u32x4 __attribute__((ext_vector_type(4)));
constexpr int BM = 256, BK = 64, HALF = 128, HTB = HALF * BK * 2  , STAGE_BYTES = 8 * HTB, NXCD = 8, WGM = 8;

__host__ __device__ __forceinline__ int lds_byte(int r, int c) { const int st = (r >> 4) * 2 + (c >> 5), rr = r & 15, cc = c & 31, ob = rr * 64 + cc * 2; return st * 1024 + (ob ^ (((ob >> 9) & 1) << 5)); }
__host__ __device__ __forceinline__ void stage_rc(int b, int& R, int& C) { const int st = b / 1024, sb = b % 1024, swz = sb ^ (((sb >> 9) & 1) << 5); R = (st >> 1) * 16 + swz / 64; C = (st & 1) * 32 + (swz % 64) / 2; }
__host__ __device__ __forceinline__ int perm32(int rho) { const int n = rho >> 4, i = rho & 15; return 8 * (i >> 2) + 4 * n + (i & 3); }

struct Unit { int pm, pn; };
struct Gemm { const bf16_t* A; const bf16_t* Bt; int M, N, K; };

struct StaticOrder {
    int nM, nN, nwg, G, c;
    __host__ __device__ void init(int M, int N, int G_, int c_) { nM = M / BM; nN = N / BM; nwg = nM * nN; G = G_; c = c_; }
    __host__ __device__ bool next(int i, Unit& u) const {
        const long L = (long)i * G + c; if (L >= nwg) return false;
        int wgid = (int)L; { const int q = nwg / NXCD, r = nwg % NXCD, xcd = wgid % NXCD, off = wgid / NXCD; wgid = (xcd < r ? xcd * (q + 1) : r * (q + 1) + (xcd - r) * q) + off; }
        const int nig = WGM * nN, gid = wgid / nig, fm = gid * WGM, gsz = (nM - fm) < WGM ? (nM - fm) : WGM;
        u.pm = fm + ((wgid % nig) % gsz); u.pn = (wgid % nig) / gsz; return true;
    }
    __device__ __forceinline__ void a_ready(const Unit&) const {}
    __device__ __forceinline__ void done(const Unit&) const {}
};

__device__ __forceinline__ unsigned cvt_pk_bf16(float lo, float hi) { unsigned r; asm volatile("v_cvt_pk_bf16_f32 %0, %1, %2" : "=v"(r) : "v"(lo), "v"(hi)); return r; }
constexpr int MROWS = 16384;
constexpr float RMS_EPS_F = 1e-6f;
__device__ __forceinline__ float row_rstd(const float* ssq, int row) {
    const f32x4 v = *(const f32x4*)(ssq + (size_t)row * 4);
    return __builtin_amdgcn_rsqf(((v[0] + v[1]) + (v[2] + v[3])) * (1.0f / 1024.0f) + RMS_EPS_F);
}
struct EpiQKV {
    static constexpr bool PERM = true, AFTER_DRAIN = false;
    bf16_t* O; int ldc; const float* bias; const float* ssq;
    __device__ __forceinline__ void operator()(const f32x4 (&acc)[2][2][4][2], const Unit& u, int wr, int wc, int fr, int fq) const {
        const int row0 = u.pm * BM + wr * 64 + fr; const int col0 = u.pn * BM + wc * 32 + 8 * fq;
        f32x4 bv[2][2];
#pragma unroll
        for (int bj = 0; bj < 2; ++bj)
#pragma unroll
            for (int n = 0; n < 2; ++n) bv[bj][n] = *(const f32x4*)(bias + col0 + bj * HALF + 4 * n);
#pragma unroll
        for (int ai = 0; ai < 2; ++ai)
#pragma unroll
            for (int m = 0; m < 4; ++m) { const int row = row0 + ai * HALF + m * 16; const float rs = row_rstd(ssq, row); bf16_t* rowp = O + (size_t)row * ldc + col0;
#pragma unroll
                for (int bj = 0; bj < 2; ++bj) { const f32x4 v0 = acc[ai][bj][m][0] * rs + bv[bj][0], v1 = acc[ai][bj][m][1] * rs + bv[bj][1];
                    u32x4 w; w.x = cvt_pk_bf16(v0[0], v0[1]); w.y = cvt_pk_bf16(v0[2], v0[3]); w.z = cvt_pk_bf16(v1[0], v1[1]); w.w = cvt_pk_bf16(v1[2], v1[3]);
                    *(u32x4*)(rowp + bj * HALF) = w; } }
    }
};
__device__ __forceinline__ float silu_mul(float g, float up) { const float e = __builtin_amdgcn_exp2f(g * -1.4426950408889634f); return g * up * __builtin_amdgcn_rcpf(1.0f + e); }
struct EpiSwiGLU {
    static constexpr bool PERM = true, AFTER_DRAIN = false;
    bf16_t* O; int ldo; const float* bias; const float* ssq;
    __device__ __forceinline__ void operator()(const f32x4 (&acc)[2][2][4][2], const Unit& u, int wr, int wc, int fr, int fq) const {
        const int row0 = u.pm * BM + wr * 64 + fr; const int col0 = u.pn * BM + wc * 32 + 8 * fq; const int ocol = u.pn * HALF + wc * 32 + 8 * fq;
        f32x4 bv[2][2];
#pragma unroll
        for (int bj = 0; bj < 2; ++bj)
#pragma unroll
            for (int n = 0; n < 2; ++n) bv[bj][n] = *(const f32x4*)(bias + col0 + bj * HALF + 4 * n);
#pragma unroll
        for (int ai = 0; ai < 2; ++ai)
#pragma unroll
            for (int m = 0; m < 4; ++m) { const int row = row0 + ai * HALF + m * 16; const float rs = row_rstd(ssq, row);
                const f32x4 g0 = acc[ai][0][m][0] * rs + bv[0][0], g1 = acc[ai][0][m][1] * rs + bv[0][1], u0 = acc[ai][1][m][0] * rs + bv[1][0], u1 = acc[ai][1][m][1] * rs + bv[1][1];
                u32x4 w; w.x = cvt_pk_bf16(silu_mul(g0[0], u0[0]), silu_mul(g0[1], u0[1])); w.y = cvt_pk_bf16(silu_mul(g0[2], u0[2]), silu_mul(g0[3], u0[3]));
                w.z = cvt_pk_bf16(silu_mul(g1[0], u1[0]), silu_mul(g1[1], u1[1])); w.w = cvt_pk_bf16(silu_mul(g1[2], u1[2]), silu_mul(g1[3], u1[3]));
                *(u32x4*)(O + (size_t)row * ldo + ocol) = w; }
    }
};
__device__ __forceinline__ f32x4 bf_lo4(unsigned a, unsigned b) { return (f32x4){__builtin_bit_cast(float, a << 16), __builtin_bit_cast(float, a & 0xffff0000u), __builtin_bit_cast(float, b << 16), __builtin_bit_cast(float, b & 0xffff0000u)}; }
template <bool XF32>
struct EpiResid {
    static constexpr bool PERM = true, AFTER_DRAIN = true;
    const float* xin; bf16_t* xb; bf16_t* xlo; float* ssq_out;
    __device__ __forceinline__ void fused(f32x4 (&acc)[2][2][4][2], const Unit& u, int wr, int wc, int fr, int fq, PG8_LAS unsigned char* lds, int wid, int lane) const {
        PG8_LAS float* P = (PG8_LAS float*)lds;
        const int col0 = u.pn * BM + wc * 32 + 8 * fq;
#pragma unroll
        for (int ai = 0; ai < 2; ++ai)
#pragma unroll
            for (int m = 0; m < 4; ++m) { const int rl = ai * HALF + wr * 64 + m * 16 + fr; const size_t off = (size_t)(u.pm * BM + rl) * 1024 + col0; float s = 0.f;
#pragma unroll
                for (int bj = 0; bj < 2; ++bj) {
                    f32x4 x0, x1;
                    if (XF32) { x0 = *(const f32x4*)(xin + off + bj * HALF); x1 = *(const f32x4*)(xin + off + bj * HALF + 4); }
                    else { const u32x4 h = *(const u32x4*)(xb + off + bj * HALF), lw = *(const u32x4*)(xlo + off + bj * HALF);
                           x0 = bf_lo4(h.x, h.y) + bf_lo4(lw.x, lw.y); x1 = bf_lo4(h.z, h.w) + bf_lo4(lw.z, lw.w); }
                    const f32x4 v0 = x0 + acc[ai][bj][m][0], v1 = x1 + acc[ai][bj][m][1];
                    s += (v0[0] * v0[0] + v0[1] * v0[1]) + (v0[2] * v0[2] + v0[3] * v0[3]) + (v1[0] * v1[0] + v1[1] * v1[1]) + (v1[2] * v1[2] + v1[3] * v1[3]);
                    u32x4 w; w.x = cvt_pk_bf16(v0[0], v0[1]); w.y = cvt_pk_bf16(v0[2], v0[3]); w.z = cvt_pk_bf16(v1[0], v1[1]); w.w = cvt_pk_bf16(v1[2], v1[3]);
                    const f32x4 r0 = v0 - bf_lo4(w.x, w.y), r1 = v1 - bf_lo4(w.z, w.w);
                    u32x4 q; q.x = cvt_pk_bf16(r0[0], r0[1]); q.y = cvt_pk_bf16(r0[2], r0[3]); q.z = cvt_pk_bf16(r1[0], r1[1]); q.w = cvt_pk_bf16(r1[2], r1[3]);
                    *(u32x4*)(xb + off + bj * HALF) = w; *(u32x4*)(xlo + off + bj * HALF) = q; }
                s += __shfl_xor(s, 16); s += __shfl_xor(s, 32);
                if (fq == 0) P[rl * 4 + wc] = s;
                if ((m & 3) == 3) asm volatile("" ::: "memory"); }
        asm volatile("s_waitcnt lgkmcnt(0)" ::: "memory"); __builtin_amdgcn_s_barrier(); asm volatile("" ::: "memory");
        if (lane < 32) { const int row = wid * 32 + lane; const float t = (P[row * 4 + 0] + P[row * 4 + 1]) + (P[row * 4 + 2] + P[row * 4 + 3]);
            ssq_out[(size_t)(u.pm * BM + row) * 4 + u.pn] = t; }
        asm volatile("s_waitcnt lgkmcnt(0)" ::: "memory"); __builtin_amdgcn_s_barrier(); asm volatile("" ::: "memory");
    }
};
struct EpiNull {
    static constexpr bool PERM = true, AFTER_DRAIN = false;
    __device__ __forceinline__ void operator()(const f32x4 (&acc)[2][2][4][2], const Unit& u, int wr, int wc, int fr, int fq) const {
#pragma unroll
        for (int ai = 0; ai < 2; ++ai)
#pragma unroll
            for (int bj = 0; bj < 2; ++bj)
#pragma unroll
                for (int m = 0; m < 4; ++m)
#pragma unroll
                    for (int n = 0; n < 2; ++n) asm volatile("" :: "v"(acc[ai][bj][m][n]));
    }
};
template <class Epi, class Sched, bool ALIGN_EPI = false, bool SP2 = false>
__device__ __forceinline__ void gemm_phase(PG8_LAS unsigned char* lds, const Gemm g, const Sched& S, const Epi& E) {
    int tid_ = threadIdx.x; asm volatile("" : "+v"(tid_));
    const int tid = tid_, wid = __builtin_amdgcn_readfirstlane(tid >> 6), lane = tid & 63, wr = wid >> 2, wc = wid & 3, fr = lane & 15, fq = lane >> 4;
    const int K = g.K, nt = K / BK;
    unsigned voffA[2], voffB[2];
#pragma unroll
    for (int i = 0; i < 2; ++i) { int R, C; stage_rc(tid * 16 + i * 8192, R, C); const int Rb = Epi::PERM ? ((R & ~31) + perm32(R & 31)) : R;
        voffA[i] = (unsigned)(R * K + C) * 2u; voffB[i] = (unsigned)(Rb * K + C) * 2u; }
    const size_t kstep = (size_t)(BK * 2);
    const size_t hstep = (size_t)HALF * K * 2;
    const size_t tstep = 2 * hstep;
    const unsigned ldsw = (unsigned)wid * 1024u;
    const int aoff = lds_byte(wr * 64 + fr, fq * 8), boff = lds_byte(wc * 32 + fr, fq * 8);
#define PG8_SA(b, h) (((b) * 2 + (h)) * HTB)
#define PG8_SB(b, h) ((4 + (b) * 2 + (h)) * HTB)
#define PG8_STAGE(bufoff, gbase, voff) do { _Pragma("unroll") for (int _i = 0; _i < 2; ++_i) \
        __builtin_amdgcn_global_load_lds((const unsigned*)((const char*)(gbase) + (voff)[_i]), (PG8_LAS unsigned*)(lds + (bufoff) + ldsw + _i * 8192), 16, 0, 0); } while (0)
#define PG8_LDA(dst, b, h) do { _Pragma("unroll") for (int m = 0; m < 4; ++m) _Pragma("unroll") for (int k = 0; k < 2; ++k) dst[m][k] = *(const PG8_LAS bf16x8*)(lds + PG8_SA(b, h) + aoff + m * 2048 + k * 1024); } while (0)
#define PG8_LDB(dst, b, h) do { _Pragma("unroll") for (int n = 0; n < 2; ++n) _Pragma("unroll") for (int k = 0; k < 2; ++k) dst[n][k] = *(const PG8_LAS bf16x8*)(lds + PG8_SB(b, h) + boff + n * 2048 + k * 1024); } while (0)
#define PG8_MMA(ai, bj, At, Bt) do { __builtin_amdgcn_s_setprio(1); _Pragma("unroll") for (int m = 0; m < 4; ++m) _Pragma("unroll") for (int n = 0; n < 2; ++n) _Pragma("unroll") for (int k = 0; k < 2; ++k) \
        acc[ai][bj][m][n] = __builtin_amdgcn_mfma_f32_16x16x32_bf16(Bt[n][k], At[m][k], acc[ai][bj][m][n], 0, 0, 0); __builtin_amdgcn_s_setprio(0); } while (0)
#define PG8_WAIT_V(n) asm volatile("s_waitcnt vmcnt(" #n ")" ::: "memory")
#define PG8_WAIT_L(n) asm volatile("s_waitcnt lgkmcnt(" #n ")" ::: "memory")
#define PG8_BAR __builtin_amdgcn_s_barrier()
#define PG8_SCHED __builtin_amdgcn_sched_barrier(0)
    Unit cur, nxt; int ui = 0;
    if (!S.next(0, cur)) return;
    f32x4 acc[2][2][4][2];
#pragma unroll
    for (int a = 0; a < 2; ++a)
#pragma unroll
        for (int b = 0; b < 2; ++b)
#pragma unroll
            for (int m = 0; m < 4; ++m)
#pragma unroll
                for (int n = 0; n < 2; ++n) acc[a][b][m][n] = (f32x4){0.f, 0.f, 0.f, 0.f};
    bf16x8 At[4][2], B0[2][2], B1[2][2];
    const char* cA = (const char*)g.A + (size_t)cur.pm * tstep; const char* cB = (const char*)g.Bt + (size_t)cur.pn * tstep;
    S.a_ready(cur);
    if constexpr (SP2) {
        PG8_STAGE(PG8_SB(0, 0), cB, voffB); PG8_STAGE(PG8_SB(0, 1), cB + hstep, voffB); PG8_STAGE(PG8_SA(0, 0), cA, voffA); PG8_STAGE(PG8_SA(0, 1), cA + hstep, voffA);
        if (wr == 1) PG8_BAR;
        PG8_WAIT_V(2); PG8_BAR;
        PG8_STAGE(PG8_SB(1, 0), cB + kstep, voffB); PG8_STAGE(PG8_SA(1, 0), cA + kstep, voffA); PG8_STAGE(PG8_SB(1, 1), cB + hstep + kstep, voffB);
        PG8_WAIT_V(6); PG8_BAR;
    } else {
        PG8_STAGE(PG8_SB(0, 0), cB, voffB); PG8_STAGE(PG8_SA(0, 0), cA, voffA); PG8_STAGE(PG8_SB(0, 1), cB + hstep, voffB); PG8_STAGE(PG8_SA(0, 1), cA + hstep, voffA);
        if (wr == 1) PG8_BAR;
        PG8_WAIT_V(4); PG8_BAR;
        PG8_STAGE(PG8_SB(1, 0), cB + kstep, voffB); PG8_STAGE(PG8_SA(1, 0), cA + kstep, voffA); PG8_STAGE(PG8_SB(1, 1), cB + hstep + kstep, voffB);
        PG8_WAIT_V(6); PG8_BAR;
    }
    for (;;) {
        const bool has_next = S.next(ui + 1, nxt);
        const char* nA = has_next ? (const char*)g.A + (size_t)nxt.pm * tstep : cA; const char* nB = has_next ? (const char*)g.Bt + (size_t)nxt.pn * tstep : cB;
        for (int t = 0; t < nt; t += 2) {
            const bool last = (t == nt - 2);
            const char* a1 = cA + (size_t)(t + 1) * kstep;
            const char* a2 = last ? nA : cA + (size_t)(t + 2) * kstep; const char* b2 = last ? nB : cB + (size_t)(t + 2) * kstep;
            const char* a3 = a2 + kstep; const char* b3 = b2 + kstep;
            if (last && has_next) S.a_ready(nxt);
            if constexpr (SP2) {
            PG8_LDB(B0, 0, 0); PG8_LDB(B1, 0, 1); PG8_SCHED; PG8_LDA(At, 0, 0); PG8_STAGE(PG8_SA(1, 1), a1 + hstep, voffA);
            PG8_WAIT_V(8); PG8_WAIT_L(0); PG8_BAR; PG8_MMA(0, 0, At, B0); PG8_MMA(0, 1, At, B1); PG8_BAR; PG8_SCHED;
            PG8_LDA(At, 0, 1); PG8_STAGE(PG8_SB(0, 0), b2, voffB); PG8_STAGE(PG8_SB(0, 1), b2 + hstep, voffB); PG8_STAGE(PG8_SA(0, 0), a2, voffA);
            PG8_WAIT_V(8); PG8_WAIT_L(0); PG8_BAR; PG8_MMA(1, 0, At, B0); PG8_MMA(1, 1, At, B1); PG8_BAR; PG8_SCHED;
            PG8_LDB(B0, 1, 0); PG8_LDB(B1, 1, 1); PG8_SCHED; PG8_LDA(At, 1, 0); PG8_STAGE(PG8_SA(0, 1), a2 + hstep, voffA);
            PG8_WAIT_V(8); PG8_WAIT_L(0); PG8_BAR; PG8_MMA(0, 0, At, B0); PG8_MMA(0, 1, At, B1); PG8_BAR; PG8_SCHED;
            PG8_LDA(At, 1, 1); PG8_STAGE(PG8_SB(1, 0), b3, voffB); PG8_STAGE(PG8_SB(1, 1), b3 + hstep, voffB); PG8_STAGE(PG8_SA(1, 0), a3, voffA);
            PG8_WAIT_V(8); PG8_WAIT_L(0); PG8_BAR; PG8_MMA(1, 0, At, B0); PG8_MMA(1, 1, At, B1); PG8_BAR; PG8_SCHED;
            } else {
            PG8_LDB(B0, 0, 0); PG8_SCHED; PG8_LDA(At, 0, 0); PG8_STAGE(PG8_SA(1, 1), a1 + hstep, voffA);
            PG8_WAIT_L(8); PG8_BAR; PG8_WAIT_L(0); PG8_MMA(0, 0, At, B0); PG8_BAR; PG8_SCHED;
            PG8_LDB(B1, 0, 1); PG8_STAGE(PG8_SB(0, 0), b2, voffB);
            PG8_BAR; PG8_WAIT_L(0); PG8_MMA(0, 1, At, B1); PG8_BAR;
            PG8_LDA(At, 0, 1); PG8_STAGE(PG8_SA(0, 0), a2, voffA);
            PG8_BAR; PG8_WAIT_L(0); PG8_MMA(1, 0, At, B0); PG8_BAR; PG8_SCHED;
            PG8_STAGE(PG8_SB(0, 1), b2 + hstep, voffB);
            PG8_WAIT_V(6); PG8_BAR; PG8_MMA(1, 1, At, B1); PG8_BAR;
            PG8_LDB(B0, 1, 0); PG8_SCHED; PG8_LDA(At, 1, 0); PG8_STAGE(PG8_SA(0, 1), a2 + hstep, voffA);
            PG8_WAIT_L(8); PG8_BAR; PG8_WAIT_L(0); PG8_MMA(0, 0, At, B0); PG8_BAR; PG8_SCHED;
            PG8_LDB(B1, 1, 1); PG8_STAGE(PG8_SB(1, 0), b3, voffB);
            PG8_BAR; PG8_WAIT_L(0); PG8_MMA(0, 1, At, B1); PG8_BAR;
            PG8_LDA(At, 1, 1); PG8_STAGE(PG8_SA(1, 0), a3, voffA);
            PG8_BAR; PG8_WAIT_L(0); PG8_MMA(1, 0, At, B0); PG8_BAR; PG8_SCHED;
            PG8_STAGE(PG8_SB(1, 1), b3 + hstep, voffB);
            PG8_WAIT_V(6); PG8_BAR; PG8_MMA(1, 1, At, B1); PG8_BAR;
            }
        }
        if constexpr (ALIGN_EPI) { if (wr == 0) PG8_BAR; }
        if constexpr (!Epi::AFTER_DRAIN) { E(acc, cur, wr, wc, fr, fq); S.done(cur); }
        if (!has_next) break;
#pragma unroll
        for (int a = 0; a < 2; ++a)
#pragma unroll
            for (int b = 0; b < 2; ++b)
#pragma unroll
                for (int m = 0; m < 4; ++m)
#pragma unroll
                    for (int n = 0; n < 2; ++n) acc[a][b][m][n] = (f32x4){0.f, 0.f, 0.f, 0.f};
        cur = nxt; cA = nA; cB = nB; ++ui;
        if constexpr (ALIGN_EPI) { if (wr == 1) PG8_BAR; }
    }
    PG8_WAIT_V(0);
    if constexpr (!ALIGN_EPI) { if (wr == 0) PG8_BAR; }
    PG8_BAR;
    if constexpr (Epi::AFTER_DRAIN) { E.fused(acc, cur, wr, wc, fr, fq, lds, wid, lane); S.done(cur); }
#undef PG8_SA
#undef PG8_SB
#undef PG8_STAGE
#undef PG8_LDA
#undef PG8_LDB
#undef PG8_MMA
#undef PG8_WAIT_V
#undef PG8_WAIT_L
#undef PG8_BAR
#undef PG8_SCHED
}
}
#define GAS __attribute__((address_space(1)))
#define LAS __attribute__((address_space(3)))
typedef unsigned short bf16;
typedef unsigned v4u __attribute__((ext_vector_type(4)));
typedef float f32x4 __attribute__((ext_vector_type(4)));
typedef short bf16x8 __attribute__((ext_vector_type(8)));
typedef GAS unsigned gu32;
typedef GAS unsigned long long gu64;
#define RLX_AGENT __ATOMIC_RELAXED, __HIP_MEMORY_SCOPE_AGENT
#define LDS_WAIT() asm volatile("s_waitcnt lgkmcnt(0)" ::: "memory")
#define VM_WAIT() asm volatile("s_waitcnt vmcnt(0)" ::: "memory")
__device__ __forceinline__ unsigned long long rt() { return __builtin_amdgcn_s_memrealtime(); }
__device__ __forceinline__ unsigned f2bf(float f) { unsigned u = __builtin_bit_cast(unsigned, f); return (u + 0x7fffu + ((u >> 16) & 1u)) >> 16; }
__device__ __forceinline__ unsigned pk2(float lo, float hi) { return f2bf(lo) | (f2bf(hi) << 16); }

#define XB_TMO      128
#define XB_XCNT(j)  (256  + 64 * (j))
#define XB_XSUB(j)  (1280 + 64 * (j))
#define XB_XGEN(j)  (2304 + 64 * (j))
#define XB_TOP      3328
#define XB_TOPGEN   3392
#define XCD_BAR_WORDS 3456
#define XB_SPIN_CAP (1u << 18)

__device__ __forceinline__ unsigned xb_ld(unsigned* p)              { return __hip_atomic_load(p, __ATOMIC_RELAXED, __HIP_MEMORY_SCOPE_AGENT); }
__device__ __forceinline__ unsigned xb_add(unsigned* p, unsigned v) { return __hip_atomic_fetch_add(p, v, __ATOMIC_RELAXED, __HIP_MEMORY_SCOPE_AGENT); }
__device__ __forceinline__ unsigned xb_xcc_id() { return (unsigned)__builtin_amdgcn_s_getreg((3 << 11) | 20) & 0xFu; }
#define XB_SPIN(cond, bar) do { unsigned _sp = 0; while (cond) { __builtin_amdgcn_s_sleep(1); \
    if ((++_sp & 255u) == 0u) { if (xb_ld(&(bar)[XB_TMO])) break; if (_sp > XB_SPIN_CAP) { atomicAdd(&(bar)[XB_TMO], 1u); break; } } } } while (0)

struct XcdBarrier {
    unsigned* bar; unsigned x;
    volatile LAS unsigned* st;
};

__device__ __forceinline__ XcdBarrier xcd_barrier_post(unsigned* bar, volatile LAS unsigned* st) {
    XcdBarrier b; b.bar = bar; b.x = xb_xcc_id(); b.st = st;
    if (threadIdx.x == 0) (void)xb_add(&bar[XB_XCNT(b.x)], 1u);
    return b;
}
__device__ __forceinline__ void xcd_barrier_complete(unsigned* bar, unsigned x, unsigned& nloc, unsigned& nx) {
    const unsigned G = gridDim.x * gridDim.y * gridDim.z;
    unsigned sum, cnt, mine, sp = 0u;
    for (;;) {
        sum = 0u; cnt = 0u; mine = 0u;
#pragma unroll
        for (unsigned j = 0; j < 16; ++j) { const unsigned c = xb_ld(&bar[XB_XCNT(j)]); sum += c; cnt += (c > 0u) ? 1u : 0u; mine = (j == x) ? c : mine; }
        if (sum == G) break;
        __builtin_amdgcn_s_sleep(1);
        if ((++sp & 255u) == 0u) { if (xb_ld(&bar[XB_TMO])) break; if (sp > XB_SPIN_CAP) { atomicAdd(&bar[XB_TMO], 1u); break; } }
    }
    nloc = mine > 0u ? mine : 1u; nx = cnt > 0u ? cnt : 1u;
}

__device__ __forceinline__ void xcd_barrier(const XcdBarrier& b) {
    asm volatile("s_waitcnt vmcnt(0)" ::: "memory");
    __syncthreads();
    if (threadIdx.x == 0) {
        unsigned* bar = b.bar;
        __builtin_amdgcn_s_waitcnt(0);
        unsigned nloc = b.st[0], nx = b.st[1];
        if (nloc == 0u) { xcd_barrier_complete(bar, b.x, nloc, nx); b.st[0] = nloc; b.st[1] = nx; }
        const unsigned old = xb_add(&bar[XB_XSUB(b.x)], 1u);
        const unsigned gen = old / nloc;
        if (old + 1u == (gen + 1u) * nloc) {
            __builtin_amdgcn_fence(__ATOMIC_RELEASE, "agent");
            asm volatile("s_waitcnt vmcnt(0)" ::: "memory");
            const unsigned og = xb_add(&bar[XB_TOP], 1u);
            const unsigned tg = og / nx;
            if (og + 1u == (tg + 1u) * nx) xb_add(&bar[XB_TOPGEN], 1u);
            else XB_SPIN(xb_ld(&bar[XB_TOPGEN]) == tg, bar);
            __builtin_amdgcn_fence(__ATOMIC_ACQUIRE, "agent");
            xb_add(&bar[XB_XGEN(b.x)], 1u);
            asm volatile("s_waitcnt vmcnt(0)" ::: "memory");
        } else {
            XB_SPIN(xb_ld(&bar[XB_XGEN(b.x)]) == gen, bar);
            __builtin_amdgcn_fence(__ATOMIC_ACQUIRE, "agent");
            asm volatile("s_waitcnt vmcnt(0)" ::: "memory");
        }
    }
    __syncthreads();
}
typedef unsigned u32x4 __attribute__((ext_vector_type(4)));

constexpr int M = 16384, D = 1024, DEPTH = 4, DFF = 2816, NFF = 2 * DFF;
constexpr int A_QKV = 1536, B_QKV = 2304, A_OUT = 1024, B_OUT = 512;
constexpr float C2 = 0.125f * 1.4426950408889634f;
constexpr float LOG2E = 1.4426950408889634f;
constexpr int NWAVES = 8;

constexpr size_t MiB = 1u << 20;
constexpr size_t WS_CTL = 0, CTL_ZERO_BYTES = 1 * MiB;
constexpr size_t WS_MOD = 1 * MiB;
constexpr size_t WS_BIAS = 1 * MiB + 128 * 1024;
constexpr size_t WS_SSQ1 = 1 * MiB + 256 * 1024;
constexpr size_t WS_SSQ2 = 1 * MiB + 512 * 1024;
constexpr size_t WS_BIASP = 2 * MiB;
constexpr size_t WS_LSE = 4 * MiB;
constexpr size_t WS_WB = 8 * MiB;
constexpr size_t WS_XB = 104 * MiB;
constexpr size_t WS_XLO = 240 * MiB;
constexpr size_t WS_QKV = 136 * MiB;
constexpr size_t WS_O = 208 * MiB;
constexpr size_t WS_OG = 272 * MiB;
constexpr size_t WS_ACT = 136 * MiB;
constexpr size_t WS_END = 320 * MiB;
constexpr int NBIAS = 30208;
constexpr size_t WL_A = (size_t)A_QKV * D + (size_t)D * A_OUT + (size_t)NFF * D + (size_t)D * DFF;
constexpr size_t WL_B = (size_t)B_QKV * D + (size_t)D * B_OUT + (size_t)NFF * D + (size_t)D * DFF;
static_assert(WS_WB + (WL_A + WL_B) * 2 * 2 <= WS_XB, "weight copies fit");
__host__ __device__ __forceinline__ size_t wl_off(int layer) { return (size_t)(layer >> 1) * (WL_A + WL_B) + ((layer & 1) ? WL_A : 0); }
__host__ __device__ __forceinline__ int bias_off(int layer) { return (layer >> 1) * 15104 + ((layer & 1) ? 7168 : 0); }

constexpr int CW_BAR = 4096;
constexpr int RING_OFF = 0, RING_BYTES = 131072;
constexpr int WSF_OFF = RING_BYTES;
constexpr int OST_OFF = WSF_OFF + 2048;
constexpr int LDSCTL_OFF = OST_OFF + 16384, MISC_OFF = LDSCTL_OFF + 320;
constexpr int LDS_BYTES = 151552;
static_assert(MISC_OFF + 128 <= LDS_BYTES, "LDS map");

#ifndef DUP
#define DUP 0
#endif

#ifndef PROBE_A
#define PROBE_A -1
#define PROBE_B -1
#endif
#define TSTAMP(ts, k) do { if (PROBE_A >= 0 && (ts) != nullptr && blockIdx.x == 0 && threadIdx.x == 0) { asm volatile("s_waitcnt vmcnt(0) lgkmcnt(0)" ::: "memory"); (ts)[k] = __builtin_amdgcn_s_memrealtime(); } } while (0)
constexpr size_t WS_TS = 512 * 1024;

typedef float f32x16 __attribute__((ext_vector_type(16)));
typedef short s16x4 __attribute__((ext_vector_type(4)));
typedef float f32x2_t __attribute__((ext_vector_type(2))); typedef __bf16 bf16x2_t __attribute__((ext_vector_type(2)));
__device__ __forceinline__ unsigned cvtpk_s(float lo, float hi) { f32x2_t v = {lo, hi}; bf16x2_t b = __builtin_convertvector(v, bf16x2_t); return __builtin_bit_cast(unsigned, b); }
__device__ __forceinline__ int crow(int r, int hi) { return (r & 3) + 8 * (r >> 2) + 4 * hi; }
__device__ __forceinline__ s16x4 vtr(const LAS unsigned char* p) { return __builtin_bit_cast(s16x4, __builtin_amdgcn_ds_read_tr16_b64_v4i16((LAS s16x4*)p)); }
__device__ __forceinline__ float bf2f(unsigned short b) { return __builtin_bit_cast(float, (unsigned)b << 16); }

__device__ __forceinline__ f32x16 alibi_tile(const float dl, const float nslope, const float lo_f, const float hi_f, const int kind) {
    f32x16 b;
    if (kind == 0) {
#pragma unroll
        for (int r = 0; r < 16; ++r) { const float dd = dl + (float)((r & 3) + 8 * (r >> 2)); const bool ok = (dd >= lo_f) && (dd <= hi_f); b[r] = ok ? __builtin_fabsf(dd) * nslope : -INFINITY; }
    } else if (kind == 1) {
#pragma unroll
        for (int r = 0; r < 16; ++r) { const float dd = dl + (float)((r & 3) + 8 * (r >> 2)); b[r] = __builtin_fabsf(dd) * nslope; }
    } else {
        const float sg = (kind == 2) ? -nslope : nslope; const float base = sg * dl;
#pragma unroll
        for (int r = 0; r < 16; ++r) b[r] = __builtin_fmaf(sg, (float)((r & 3) + 8 * (r >> 2)), base);
    }
    return b;
}
__device__ __forceinline__ float half_swap_max(float v) { float a = v, b = v; asm volatile("s_nop 1\n\tv_permlane32_swap_b32 %0, %1\n\ts_nop 1" : "+v"(a), "+v"(b)); return __builtin_fmaxf(a, b); }
__device__ __forceinline__ float half_swap_add(float v) { float a = v, b = v; asm volatile("s_nop 1\n\tv_permlane32_swap_b32 %0, %1\n\ts_nop 1" : "+v"(a), "+v"(b)); return a + b; }
#define ATT_SB() __builtin_amdgcn_sched_barrier(0)
template <int HW, int NQT, bool SINK, int THR>
__device__ __forceinline__ void attn_unit(LAS unsigned char* lds, const bf16* __restrict__ qkv, const int pitch, const int c, const int d, const int U0, const int Ls,
                                          const int qcol0, const int kcol, const int vcol, const int hflat0, const float slope_den, const float* __restrict__ sink,
                                          bf16* __restrict__ O, const int opitch, const int ocol0, float* __restrict__ lse, const int lse_slot0, unsigned long long* ts) {
    constexpr int NKEYS = 32 * NQT + 2 * HW, NSLOT = NKEYS / 64, NKT = 1 + 2 * HW / 32, GPW = NQT / 2, MID = HW / 32;
    constexpr int K_OFF = 0, V_OFF = NSLOT * 8192;
    static_assert(2 * NSLOT * 8192 <= RING_BYTES, "K/V fit the ring region");
    int tid_ = threadIdx.x; asm volatile("" : "+v"(tid_));
    const int tid = tid_, lane = tid & 63, r32 = lane & 31, hi = lane >> 5; const int wid = __builtin_amdgcn_readfirstlane(tid >> 6);
    for (int rep_ = 0; rep_ < ((DUP == 24 && HW == 128) ? 2 : 1); ++rep_) {
    if (rep_) { asm volatile("s_waitcnt vmcnt(0)" ::: "memory"); __syncthreads(); }
#pragma unroll
    for (int s = 0; s < NSLOT; ++s) {
        { int idx = U0 - HW + 64 * s + lane; idx = idx < 0 ? 0 : (idx > Ls - 1 ? Ls - 1 : idx); const size_t tok = (size_t)c + (size_t)d * idx;
          const bf16* src = qkv + tok * pitch + kcol + 8 * wid;
          __builtin_amdgcn_global_load_lds((const unsigned*)src, (LAS unsigned*)(lds + K_OFF + s * 8192 + wid * 1024), 16, 0, 0); }
        { int idx = U0 - HW + 64 * s + 16 * (wid & 3) + (lane >> 2); idx = idx < 0 ? 0 : (idx > Ls - 1 ? Ls - 1 : idx); const size_t tok = (size_t)c + (size_t)d * idx;
          const bf16* src = qkv + tok * pitch + vcol + 32 * (wid >> 2) + 8 * (lane & 3);
          __builtin_amdgcn_global_load_lds((const unsigned*)src, (LAS unsigned*)(lds + V_OFF + s * 8192 + wid * 1024), 16, 0, 0); }
    }
    }
    const int qt = wid % NQT, gbase = (wid / NQT) * GPW;
    const int uq = U0 + 32 * qt + r32;
    const size_t qtok = (size_t)c + (size_t)d * uq;
    const bf16* qp0 = qkv + qtok * pitch + qcol0 + 8 * hi;
    bf16x8 qr[4];
#pragma unroll
    for (int d0 = 0; d0 < 4; ++d0) qr[d0] = *(const bf16x8*)(qp0 + 64 * gbase + 16 * d0);
    asm volatile("s_waitcnt vmcnt(0)" ::: "memory");
    __syncthreads();
    TSTAMP(ts, 1);
    LAS float* wsf = (LAS float*)(lds + WSF_OFF) + wid * 64;
    LAS bf16* stg = (LAS bf16*)(lds + OST_OFF) + wid * 1024;
    const bool edge = (U0 < HW) || (U0 + 32 * NQT + HW > Ls);
    const float lo_f = (float)((-uq) > -HW ? (-uq) : -HW), hi_f = (float)((Ls - 1 - uq) < HW ? (Ls - 1 - uq) : HW);
    const int vlane = ((lane >> 4) & 1) * 32 + (lane & 3) * 8 + (4 * hi + ((lane & 15) >> 2)) * 64;
    const LAS unsigned char* kbase = lds + K_OFF + hi * 1024 + r32 * 16;
    const float dl0 = (float)(4 * hi - HW - r32);
    const size_t tok0 = (size_t)c + (size_t)d * (size_t)(U0 + 32 * qt);
    for (int gg_ = 0; gg_ < ((DUP == 25 && HW == 128) ? 2 * GPW : GPW); ++gg_) {
        const int gg = gg_ % GPW; const int g = gbase + gg;
        const float slope = __builtin_amdgcn_exp2f(-8.0f * (float)(hflat0 + g + 1) / slope_den);
        const float nslope = -slope * LOG2E * (float)d;
        bf16x8 qn[4];
#pragma unroll
        for (int d0 = 0; d0 < 4; ++d0) qn[d0] = qr[d0];
        if (gg + 1 < GPW || DUP == 25) {
#pragma unroll
            for (int d0 = 0; d0 < 4; ++d0) qn[d0] = *(const bf16x8*)(qp0 + 64 * (gbase + (gg + 1) % GPW) + 16 * d0);
        }
        float m, l; f32x16 o0, o1;
        for (int rep2_ = 0; rep2_ < ((DUP == 26 && HW == 128) ? 2 : 1); ++rep2_) {
        m = SINK ? sink[g] * LOG2E : -1e30f;
        l = (SINK && hi == 0) ? 1.0f : 0.0f;
        o0 = f32x16{}; o1 = f32x16{};
        f32x16 p = alibi_tile(dl0, nslope, lo_f, hi_f, 0);
        {   const LAS unsigned char* kb = kbase + (qt >> 1) * 8192 + (qt & 1) * 512;
            const bf16x8 k0 = *(const LAS bf16x8*)(kb), k1 = *(const LAS bf16x8*)(kb + 2048), k2 = *(const LAS bf16x8*)(kb + 4096), k3 = *(const LAS bf16x8*)(kb + 6144);
            p = __builtin_amdgcn_mfma_f32_32x32x16_bf16(k0, qr[0], p, 0, 0, 0); p = __builtin_amdgcn_mfma_f32_32x32x16_bf16(k1, qr[1], p, 0, 0, 0);
            p = __builtin_amdgcn_mfma_f32_32x32x16_bf16(k2, qr[2], p, 0, 0, 0); p = __builtin_amdgcn_mfma_f32_32x32x16_bf16(k3, qr[3], p, 0, 0, 0); }
#pragma unroll 1
        for (int jj = 0; jj < NKT; ++jj) {
            const int j = qt + jj, slot = j >> 1, half = j & 1;
            const bool more = jj + 1 < NKT;
            const int j1 = more ? j + 1 : j;
            const LAS unsigned char* kb = kbase + (j1 >> 1) * 8192 + (j1 & 1) * 512;
            const bf16x8 k0 = *(const LAS bf16x8*)(kb), k1 = *(const LAS bf16x8*)(kb + 2048), k2 = *(const LAS bf16x8*)(kb + 4096), k3 = *(const LAS bf16x8*)(kb + 6144);
            const LAS unsigned char* vb = lds + V_OFF + slot * 8192 + (2 * half) * 1024 + vlane;
            const s16x4 a0 = vtr(vb), a1 = vtr(vb + 512), b0 = vtr(vb + 1024), b1 = vtr(vb + 1024 + 512);
            const s16x4 c0 = vtr(vb + 4096), c1 = vtr(vb + 4096 + 512), e0 = vtr(vb + 4096 + 1024), e1 = vtr(vb + 4096 + 1024 + 512);
            ATT_SB();
            const int kind = (edge || jj + 1 >= NKT - 1) ? 0 : (jj + 1 == MID ? 1 : (jj + 1 < MID ? 2 : 3));
            f32x16 pn = alibi_tile(dl0 + 32.0f * (float)(jj + 1), nslope, lo_f, hi_f, kind);
            ATT_SB();
            if (more) { pn = __builtin_amdgcn_mfma_f32_32x32x16_bf16(k0, qr[0], pn, 0, 0, 0); pn = __builtin_amdgcn_mfma_f32_32x32x16_bf16(k1, qr[1], pn, 0, 0, 0);
                        pn = __builtin_amdgcn_mfma_f32_32x32x16_bf16(k2, qr[2], pn, 0, 0, 0); pn = __builtin_amdgcn_mfma_f32_32x32x16_bf16(k3, qr[3], pn, 0, 0, 0); }
            ATT_SB();
            float rm = __builtin_fmaxf(p[0], p[1]);
#pragma unroll
            for (int r = 2; r < 16; ++r) rm = __builtin_fmaxf(rm, p[r]);
            rm = half_swap_max(rm);
            if (__any(rm > m + (float)THR)) {
                const float mn = __builtin_fmaxf(m, rm); const float alpha = __builtin_amdgcn_exp2f(m - mn);
                l *= alpha; m = mn;
                if (hi == 0) wsf[r32] = alpha;
                asm volatile("s_waitcnt lgkmcnt(0)" ::: "memory");
#pragma unroll
                for (int r = 0; r < 16; ++r) { const float a = wsf[crow(r, hi)]; o0[r] *= a; o1[r] *= a; }
            }
            float ls = 0.f;
#pragma unroll
            for (int r = 0; r < 16; ++r) { p[r] = __builtin_amdgcn_exp2f(p[r] - m); ls += p[r]; }
            l += ls;
            u32x4 pw0, pw1;
            pw0[0] = cvtpk_s(p[0], p[1]); pw0[1] = cvtpk_s(p[2], p[3]); pw0[2] = cvtpk_s(p[4], p[5]); pw0[3] = cvtpk_s(p[6], p[7]);
            pw1[0] = cvtpk_s(p[8], p[9]); pw1[1] = cvtpk_s(p[10], p[11]); pw1[2] = cvtpk_s(p[12], p[13]); pw1[3] = cvtpk_s(p[14], p[15]);
            const bf16x8 pa0 = __builtin_bit_cast(bf16x8, pw0), pa1 = __builtin_bit_cast(bf16x8, pw1);
            ATT_SB();
            o0 = __builtin_amdgcn_mfma_f32_32x32x16_bf16(pa0, (bf16x8){a0[0], a0[1], a0[2], a0[3], a1[0], a1[1], a1[2], a1[3]}, o0, 0, 0, 0);
            o1 = __builtin_amdgcn_mfma_f32_32x32x16_bf16(pa0, (bf16x8){c0[0], c0[1], c0[2], c0[3], c1[0], c1[1], c1[2], c1[3]}, o1, 0, 0, 0);
            o0 = __builtin_amdgcn_mfma_f32_32x32x16_bf16(pa1, (bf16x8){b0[0], b0[1], b0[2], b0[3], b1[0], b1[1], b1[2], b1[3]}, o0, 0, 0, 0);
            o1 = __builtin_amdgcn_mfma_f32_32x32x16_bf16(pa1, (bf16x8){e0[0], e0[1], e0[2], e0[3], e1[0], e1[1], e1[2], e1[3]}, o1, 0, 0, 0);
            p = pn;
        }
        }
        if (gg_ == 0) TSTAMP(ts, 2);
        const float lt = half_swap_add(l);
        if (hi == 0) { wsf[32 + r32] = __builtin_amdgcn_rcpf(lt); if (lse) lse[qtok * 8 + lse_slot0 + g] = m + __builtin_amdgcn_logf(lt); }
        asm volatile("s_waitcnt lgkmcnt(0)" ::: "memory");
        float rl[16];
#pragma unroll
        for (int r = 0; r < 16; ++r) rl[r] = wsf[32 + crow(r, hi)];
#pragma unroll
        for (int dh = 0; dh < 2; ++dh) {
#pragma unroll
            for (int r = 0; r < 16; ++r) stg[crow(r, hi) * 32 + r32] = (bf16)(cvtpk_s((dh ? o1[r] : o0[r]) * rl[r], 0.f) & 0xffffu);
            asm volatile("s_waitcnt lgkmcnt(0)" ::: "memory");
#pragma unroll
            for (int ps = 0; ps < 2; ++ps) { const int row = ps * 16 + (lane >> 2), ch = lane & 3; const u32x4 v = *(const LAS u32x4*)(stg + row * 32 + ch * 8);
                *(u32x4*)(O + (tok0 + (size_t)d * row) * opitch + ocol0 + 64 * g + 32 * dh + 8 * ch) = v; }
            asm volatile("s_waitcnt lgkmcnt(0)" ::: "memory");
        }
#pragma unroll
        for (int d0 = 0; d0 < 4; ++d0) qr[d0] = qn[d0];
        if (gg_ == 0) TSTAMP(ts, 3);
    }
    __syncthreads();
    TSTAMP(ts, 4);
}

struct Frame {
    LAS unsigned char* lds; volatile LAS unsigned* MISC; gu32* ctl;
    int tid, lane, wave, vcu, G;
    const float *x, *cvec, *ada_w, *ada_b, *norm_mix, *norm_ffn, *ffn_w_in, *ffn_w_out, *a_w_in, *a_w_out, *a_sink, *b_w_in, *b_w_out, *final_norm;
    float* out; unsigned char* ws;
    float *mod, *bias, *ssq1, *ssq2, *biasp, *lse; bf16 *wb, *xb, *xlo, *qkv, *o, *og, *act;
};
__device__ __forceinline__ float wave_sum(float v) {
#pragma unroll
    for (int o = 1; o < 64; o <<= 1) v += __shfl_xor(v, o);
    return v;
}

__device__ __forceinline__ void p0_mod_and_x(Frame& F) {
    LAS float* condl = (LAS float*)(F.lds + RING_OFF);
    for (int k = F.tid; k < D; k += NWAVES * 64) { const float cv = F.cvec[k]; condl[k] = cv / (1.0f + __expf(-cv)); }
    __syncthreads();
    if (F.wave < 6) {
        const int it = 2 * (F.vcu + F.G * (F.wave >> 1)) + (F.wave & 1);
        if (it < DEPTH * 384) {
            const int layer = it / 384, n0 = 16 * (it % 384), kq = F.lane >> 2, c4 = F.lane & 3;
            const float* W = F.ada_w + (size_t)layer * D * 6 * D + n0 + 4 * c4;
            f32x4 acc = {0.f, 0.f, 0.f, 0.f};
#pragma unroll 16
            for (int i = 0; i < 64; ++i) { const int k = kq + 16 * i; const f32x4 w = *(const f32x4*)(W + (size_t)k * 6 * D); acc += w * condl[k]; }
#pragma unroll
            for (int o = 4; o < 64; o <<= 1) { acc.x += __shfl_xor(acc.x, o); acc.y += __shfl_xor(acc.y, o); acc.z += __shfl_xor(acc.z, o); acc.w += __shfl_xor(acc.w, o); }
            if (F.lane < 4) { const f32x4 b = *(const f32x4*)(F.ada_b + (size_t)layer * 6 * D + n0 + 4 * c4); *(f32x4*)(F.mod + (size_t)layer * 6 * D + n0 + 4 * c4) = acc + b; }
        }
    }
    const int rstart = F.wave < 6 ? 5 * F.wave : 30 + 17 * (F.wave - 6), rcnt = F.wave < 6 ? 5 : 17;
    const int m0 = F.vcu * (M / F.G) + rstart;
    f32x4 v[4], vn[4];
    { const f32x4* xr = (const f32x4*)(F.x + (size_t)m0 * D) + F.lane;
#pragma unroll
      for (int j = 0; j < 4; ++j) v[j] = xr[64 * j]; }
    for (int i = 0; i < rcnt; ++i) {
        const int m = m0 + i;
        if (i + 1 < rcnt) { const f32x4* xr = (const f32x4*)(F.x + (size_t)(m + 1) * D) + F.lane;
#pragma unroll
            for (int j = 0; j < 4; ++j) vn[j] = xr[64 * j]; }
        float s = 0.f;
#pragma unroll
        for (int j = 0; j < 4; ++j) s += (v[j].x * v[j].x + v[j].y * v[j].y) + (v[j].z * v[j].z + v[j].w * v[j].w);
        s = wave_sum(s);
        if (F.lane < 4) F.ssq1[(size_t)m * 4 + F.lane] = (F.lane == 0) ? s : 0.f;
        unsigned long long* o8 = (unsigned long long*)(F.xb + (size_t)m * D) + F.lane;
#pragma unroll
        for (int j = 0; j < 4; ++j) o8[64 * j] = (unsigned long long)cvtpk_s(v[j].x, v[j].y) | ((unsigned long long)cvtpk_s(v[j].z, v[j].w) << 32);
#pragma unroll
        for (int j = 0; j < 4; ++j) v[j] = vn[j];
    }
}

__device__ __forceinline__ void prep_item(const float* __restrict__ W, const int K, const int N, const int k0, const int n0, bf16* __restrict__ WT, const int dest0,
                                          const float* __restrict__ nrm, const float* __restrict__ sc, const float* __restrict__ colmod, const float colconst,
                                          const float* __restrict__ sh, float* __restrict__ biasp_dst, LAS float* scr, const int lane) {
    {   float wv[32]; const float* wp = W + (size_t)(k0 + (lane >> 5)) * N + n0 + (lane & 31);
#pragma unroll
        for (int i = 0; i < 32; ++i) wv[i] = wp[(size_t)(2 * i) * N];
#pragma unroll
        for (int i = 0; i < 32; ++i) scr[(2 * i + (lane >> 5)) * 33 + (lane & 31)] = wv[i]; }
    asm volatile("s_waitcnt lgkmcnt(0)" ::: "memory");
    if (sh) {
        const int col = lane & 31, hb = (lane >> 5) * 32; float s = 0.f;
#pragma unroll 8
        for (int kk = 0; kk < 32; ++kk) s += sh[k0 + hb + kk] * scr[(hb + kk) * 33 + col];
        s += __shfl_xor(s, 32);
        if (lane < 32) biasp_dst[col] = s * colconst;
    }
    const int cch = lane & 7;
    float rsv[8];
#pragma unroll
    for (int e = 0; e < 8; ++e) { const int k = k0 + 8 * cch + e; rsv[e] = nrm ? nrm[k] * (1.0f + sc[k]) : 1.0f; }
#pragma unroll
    for (int j = 0; j < 4; ++j) { const int n = (lane >> 3) + 8 * j; const float cs = colconst * (colmod ? colmod[n0 + n] : 1.0f);
        const LAS float* s = scr + (8 * cch) * 33 + n;
        v4u o; o.x = cvtpk_s(s[0 * 33] * rsv[0] * cs, s[1 * 33] * rsv[1] * cs); o.y = cvtpk_s(s[2 * 33] * rsv[2] * cs, s[3 * 33] * rsv[3] * cs);
        o.z = cvtpk_s(s[4 * 33] * rsv[4] * cs, s[5 * 33] * rsv[5] * cs); o.w = cvtpk_s(s[6 * 33] * rsv[6] * cs, s[7 * 33] * rsv[7] * cs);
        *(v4u*)(WT + (size_t)(dest0 + n) * K + k0 + 8 * cch) = o; }
    asm volatile("s_waitcnt lgkmcnt(0)" ::: "memory");
}
constexpr int PREP_IA = 768 + 512 + 2816 + 1408, PREP_IB = 1152 + 256 + 2816 + 1408;
__device__ __forceinline__ void prep_range(Frame& F, const int layer, const int it_lo, const int it_hi, const int widx, const int nw, const int wave, const int lane) {
    LAS float* scr = (LAS float*)(F.lds + RING_OFF + wave * 16384);
    const int t = layer & 1, jl = layer >> 1;
    for (int it = it_lo + widx; it < it_hi; it += nw) {
        int r = it;
        const float* mod = F.mod + (size_t)layer * 6 * D;
        const int n1 = t ? B_QKV : A_QKV, k2 = t ? B_OUT : A_OUT, dq = t ? 1536 : 1024;
        bf16* wl = F.wb + wl_off(layer);
        const int I1 = (n1 / 32) * 16, I2 = 32 * (k2 / 64), I3 = (NFF / 32) * 16;
        if (r < I1) {
            const int nblk = n1 / 32, nb = r % nblk, kb = r / nblk, n0 = 32 * nb;
            const float* W = t ? F.b_w_in + (size_t)jl * D * B_QKV : F.a_w_in + (size_t)jl * D * A_QKV;
            prep_item(W, D, n1, 64 * kb, n0, wl, n0, F.norm_mix + layer * D, mod + D, nullptr, n0 < dq ? C2 : 1.0f, mod, F.biasp + (size_t)kb * NBIAS + bias_off(layer) + n0, scr, lane);
            continue; }
        r -= I1;
        if (r < I2) {
            const int nb = r % 32, kb = r / 32, n0 = 32 * nb;
            const float* W = t ? F.b_w_out + (size_t)jl * B_OUT * D : F.a_w_out + (size_t)jl * A_OUT * D;
            prep_item(W, k2, D, 64 * kb, n0, wl + (size_t)n1 * D, n0, nullptr, nullptr, mod + 2 * D, 1.0f, nullptr, nullptr, scr, lane);
            continue; }
        r -= I2;
        if (r < I3) {
            const int nblk = NFF / 32, nb = r % nblk, kb = r / nblk, n0 = 32 * nb;
            const int dest0 = n0 < DFF ? 256 * (n0 / 128) + (n0 % 128) : 256 * ((n0 - DFF) / 128) + 128 + ((n0 - DFF) % 128);
            prep_item(F.ffn_w_in + (size_t)layer * D * NFF, D, NFF, 64 * kb, n0, wl + (size_t)n1 * D + (size_t)D * k2, dest0, F.norm_ffn + layer * D, mod + 4 * D, nullptr, 1.0f, mod + 3 * D,
                      F.biasp + (size_t)kb * NBIAS + bias_off(layer) + n1 + dest0, scr, lane);
            continue; }
        r -= I3;
        {
            const int nb = r % 32, kb = r / 32, n0 = 32 * nb;
            prep_item(F.ffn_w_out + (size_t)layer * DFF * D, DFF, D, 64 * kb, n0, wl + (size_t)n1 * D + (size_t)D * k2 + (size_t)NFF * D, n0, nullptr, nullptr, mod + 5 * D, 1.0f, nullptr, nullptr, scr, lane);
        }
    }
}
__device__ __forceinline__ void bias_reduce(Frame& F, const int layer) {
    int tid_ = threadIdx.x; asm volatile("" : "+v"(tid_));
    const int idx = blockIdx.x * (NWAVES * 64) + tid_, n = ((layer & 1) ? B_QKV : A_QKV) + NFF, off = bias_off(layer);
    for (int i = idx; i < n; i += F.G * NWAVES * 64) { float s = 0.f;
#pragma unroll
        for (int kb = 0; kb < 16; ++kb) s += F.biasp[(size_t)kb * NBIAS + off + i];
        F.bias[off + i] = s; }
}
__device__ __forceinline__ void tail_prep(Frame& F, const int layer_next, const int nunits, const int part) {
    const int rem = nunits % F.G; if (rem == 0) return;
    const int c = (int)blockIdx.x; if (c < rem) return;
    const int prev_t = (layer_next - 1) & 1;
    const int ns1 = F.G - ((prev_t ? (M / 256) * (B_QKV / 256) : (M / 256) * (A_QKV / 256)) % F.G), ns3 = F.G - (((M / 256) * (NFF / 256)) % F.G);
    const int IL = (layer_next & 1) ? PREP_IB : PREP_IA;
    const int cut = (int)((long)IL * ns1 / (ns1 + ns3));
    int tid_ = threadIdx.x; asm volatile("" : "+v"(tid_)); const int wave = __builtin_amdgcn_readfirstlane(tid_ >> 6), lane = tid_ & 63;
    prep_range(F, layer_next, part == 0 ? 0 : cut, part == 0 ? cut : IL, (c - rem) * NWAVES + wave, (F.G - rem) * NWAVES, wave, lane);
}
__device__ __forceinline__ void merge_groups(Frame& F) {
    const int gw = F.vcu * NWAVES + F.wave, NGW = F.G * NWAVES;
    for (int m = gw; m < M; m += NGW) {
        const int slot = F.lane >> 3;
        const float l0 = F.lse[(size_t)m * 8 + slot], l1 = F.lse[(size_t)M * 8 + (size_t)m * 8 + slot], l2 = F.lse[(size_t)2 * M * 8 + (size_t)m * 8 + slot];
        const float mx = __builtin_fmaxf(__builtin_fmaxf(l0, l1), l2);
        float w0 = __builtin_amdgcn_exp2f(l0 - mx), w1 = __builtin_amdgcn_exp2f(l1 - mx), w2 = __builtin_amdgcn_exp2f(l2 - mx);
        const float inv = __builtin_amdgcn_rcpf(w0 + w1 + w2); w0 *= inv; w1 *= inv; w2 *= inv;
        const v4u a = *(const v4u*)(F.og + (size_t)m * 512 + 8 * F.lane), b = *(const v4u*)(F.og + (size_t)M * 512 + (size_t)m * 512 + 8 * F.lane), cc = *(const v4u*)(F.og + (size_t)2 * M * 512 + (size_t)m * 512 + 8 * F.lane);
        v4u o;
#pragma unroll
        for (int e = 0; e < 4; ++e) {
            const float lo = w0 * __builtin_bit_cast(float, a[e] << 16) + w1 * __builtin_bit_cast(float, b[e] << 16) + w2 * __builtin_bit_cast(float, cc[e] << 16);
            const float hi = w0 * __builtin_bit_cast(float, a[e] & 0xffff0000u) + w1 * __builtin_bit_cast(float, b[e] & 0xffff0000u) + w2 * __builtin_bit_cast(float, cc[e] & 0xffff0000u);
            o[e] = cvtpk_s(lo, hi); }
        *(v4u*)(F.o + (size_t)m * 512 + 8 * F.lane) = o;
    }
}
__device__ __forceinline__ void final_norm(Frame& F) {
    const int gw = F.vcu * NWAVES + F.wave, NGW = F.G * NWAVES;
    for (int m = gw; m < M; m += NGW) {
        const float rs = pg8::row_rstd(F.ssq1, m);
        f32x4* orow = (f32x4*)(F.out + (size_t)m * D); const f32x4* fw = (const f32x4*)F.final_norm;
        const v4u* hr = (const v4u*)(F.xb + (size_t)m * D); const v4u* lr = (const v4u*)(F.xlo + (size_t)m * D);
#pragma unroll
        for (int j = 0; j < 2; ++j) { const int c8 = 64 * j + F.lane;
            const v4u h = hr[c8], lw = lr[c8];
            const f32x4 v0 = pg8::bf_lo4(h.x, h.y) + pg8::bf_lo4(lw.x, lw.y), v1 = pg8::bf_lo4(h.z, h.w) + pg8::bf_lo4(lw.z, lw.w);
            orow[2 * c8] = v0 * rs * fw[2 * c8]; orow[2 * c8 + 1] = v1 * rs * fw[2 * c8 + 1]; }
    }
}

#ifndef MK_MULTI
#define MK_MULTI 0
#endif
#ifndef TAILPREP
#define TAILPREP 1
#endif
#ifndef ATT_THR
#define ATT_THR 6
#endif
constexpr int NPHASES = 3 + 6 * DEPTH + 1;
struct Args { const float* in[14]; float* out; unsigned char* ws; int ph_lo, ph_hi; };
__global__ void __launch_bounds__(NWAVES * 64, 2) fwd_kernel(Args args) {
    extern __shared__ __attribute__((aligned(16))) unsigned char lds_raw[];
    Frame F;
    F.lds = (LAS unsigned char*)lds_raw; F.MISC = (volatile LAS unsigned*)(F.lds + MISC_OFF);
    F.tid = threadIdx.x; F.lane = F.tid & 63; F.wave = __builtin_amdgcn_readfirstlane(F.tid >> 6);
    F.G = gridDim.x; { const int bx = blockIdx.x; F.vcu = (F.G % 8 == 0) ? (bx % 8) * (F.G / 8) + bx / 8 : bx; }
    unsigned char* ws = args.ws; F.ws = ws; F.ctl = (gu32*)(ws + WS_CTL);
    F.x = args.in[0]; F.cvec = args.in[1]; F.ada_w = args.in[2]; F.ada_b = args.in[3]; F.norm_mix = args.in[4]; F.norm_ffn = args.in[5]; F.ffn_w_in = args.in[6]; F.ffn_w_out = args.in[7];
    F.a_w_in = args.in[8]; F.a_w_out = args.in[9]; F.a_sink = args.in[10]; F.b_w_in = args.in[11]; F.b_w_out = args.in[12]; F.final_norm = args.in[13]; F.out = args.out;
    F.mod = (float*)(ws + WS_MOD); F.bias = (float*)(ws + WS_BIAS); F.ssq1 = (float*)(ws + WS_SSQ1); F.ssq2 = (float*)(ws + WS_SSQ2); F.biasp = (float*)(ws + WS_BIASP); F.lse = (float*)(ws + WS_LSE);
    F.wb = (bf16*)(ws + WS_WB); F.xb = (bf16*)(ws + WS_XB); F.xlo = (bf16*)(ws + WS_XLO); F.qkv = (bf16*)(ws + WS_QKV); F.o = (bf16*)(ws + WS_O); F.og = (bf16*)(ws + WS_OG); F.act = (bf16*)(ws + WS_ACT);
    for (int u = F.tid; u < (LDS_BYTES - LDSCTL_OFF) / 4; u += NWAVES * 64) ((LAS unsigned*)(F.lds + LDSCTL_OFF))[u] = 0u;
    __syncthreads();
    const int lo = args.ph_lo, hi = args.ph_hi;
    unsigned long long* ts = (unsigned long long*)(ws + WS_TS);
    TSTAMP(ts, 8);
    XcdBarrier bar; bar.bar = (unsigned*)(F.ctl + CW_BAR); bar.x = 0; bar.st = nullptr;
    if (hi - lo > 1) bar = xcd_barrier_post((unsigned*)(F.ctl + CW_BAR), F.MISC + 8);
#define RUN(p) (lo <= (p) && (p) < hi)
#define SEAM(p) do { if (RUN(p) && RUN((p) + 1)) { xcd_barrier(bar); if (DUP == 7) xcd_barrier(bar); } } while (0)

    for (int rep = 0; rep < (DUP == 6 ? 2 : 1); ++rep) {
    if (RUN(0)) { p0_mod_and_x(F); } TSTAMP(ts, 9); SEAM(0); TSTAMP(ts, 10);
    if (RUN(1)) { for (int ly = 0; ly < (TAILPREP ? 1 : DEPTH); ++ly) prep_range(F, ly, 0, (ly & 1) ? PREP_IB : PREP_IA, F.vcu * NWAVES + F.wave, F.G * NWAVES, F.wave, F.lane); } TSTAMP(ts, 11); SEAM(1); TSTAMP(ts, 12);
    if (RUN(2)) { for (int ly = 0; ly < (TAILPREP ? 1 : DEPTH); ++ly) bias_reduce(F, ly); } SEAM(2); TSTAMP(ts, 13);
    }

    for (int layer = 0; layer < DEPTH; ++layer) {
        const int pb = 3 + 6 * layer, t = layer & 1, jl = layer >> 1;
        const int n1 = t ? B_QKV : A_QKV, k2 = t ? B_OUT : A_OUT;
        const bf16* wl = F.wb + wl_off(layer);
        const float* bias1 = F.bias + bias_off(layer);
        unsigned long long* tsl = layer == 0 ? ts : nullptr;
        TSTAMP(tsl, 16);
        for (int rep = 0; rep < (DUP == 1 ? 2 : 1); ++rep) {
        if (RUN(pb)) {
            pg8::Gemm g{F.xb, wl, M, n1, D}; pg8::StaticOrder S; S.init(M, n1, F.G, (int)blockIdx.x);
            pg8::EpiQKV E{F.qkv, n1, bias1, F.ssq1};
            pg8::gemm_phase<pg8::EpiQKV, pg8::StaticOrder, true, true>(F.lds + RING_OFF, g, S, E);
            if (TAILPREP && layer + 1 < DEPTH) tail_prep(F, layer + 1, (M / 256) * (n1 / 256), 0);
        }
        SEAM(pb);
        }
        TSTAMP(tsl, 0);
        for (int rep = 0; rep < ((DUP == 2 || (DUP == 21 && t == 0) || (DUP == 22 && t == 1)) ? 2 : 1); ++rep) {
        if (RUN(pb + 1)) {
            if (t == 0) {
                for (int u = F.vcu; u < 256; u += F.G) { const int qb = u >> 2, hkv = u & 3;
                    attn_unit<128, 8, true, ATT_THR>(F.lds + RING_OFF, F.qkv, A_QKV, 0, 1, 256 * qb, M, 256 * hkv, 1024 + 64 * hkv, 1280 + 64 * hkv, 4 * hkv, 16.0f, F.a_sink + jl * 16 + 4 * hkv,
                                                   F.o, 1024, 256 * hkv, nullptr, 0, layer == 0 ? ts : nullptr); }
            } else {
                for (int u = F.vcu; u < 768; u += F.G) { const int gi = u >> 8, rem = u & 255, hkv = rem & 1, cb = rem >> 1; const int dd = 1 << (2 * gi), cc = cb & (dd - 1), blk = cb >> (2 * gi);
                    attn_unit<64, 4, false, ATT_THR>(F.lds + RING_OFF, F.qkv, B_QKV, cc, dd, 128 * blk, M >> (2 * gi), (gi * 8 + hkv * 4) * 64, 1536 + (gi * 2 + hkv) * 64, 1920 + (gi * 2 + hkv) * 64,
                                                   gi * 8 + hkv * 4, 24.0f, nullptr, F.og + (size_t)gi * M * 512, 512, 256 * hkv, F.lse + (size_t)gi * M * 8, 4 * hkv, nullptr); }
            }
        }
        SEAM(pb + 1);
        TSTAMP(tsl, 17);
        if (RUN(pb + 2)) { if (t == 1) { merge_groups(F); if (DUP == 23) { xcd_barrier(bar); merge_groups(F); } } }
        if (t == 1) SEAM(pb + 2);
        }
        TSTAMP(tsl, 18);
        if (RUN(pb + 3)) {
            pg8::Gemm g{F.o, wl + (size_t)n1 * D, M, D, k2}; pg8::StaticOrder S; S.init(M, D, F.G, (int)blockIdx.x);
            if (layer == 0) { pg8::EpiResid<true> E{F.x, F.xb, F.xlo, F.ssq2}; pg8::gemm_phase<pg8::EpiResid<true>, pg8::StaticOrder, false, true>(F.lds + RING_OFF, g, S, E); }
            else { pg8::EpiResid<false> E{nullptr, F.xb, F.xlo, F.ssq2}; pg8::gemm_phase<pg8::EpiResid<false>, pg8::StaticOrder, false, true>(F.lds + RING_OFF, g, S, E); }
        }
        SEAM(pb + 3);
        TSTAMP(tsl, 5);
        for (int rep = 0; rep < (DUP == 4 ? 2 : 1); ++rep) {
        if (RUN(pb + 4)) {
            pg8::Gemm g{F.xb, wl + (size_t)n1 * D + (size_t)D * k2, M, NFF, D}; pg8::StaticOrder S; S.init(M, NFF, F.G, (int)blockIdx.x);
            pg8::EpiSwiGLU E{F.act, DFF, bias1 + n1, F.ssq2};
            if (DUP == 41) { pg8::EpiNull EN; pg8::gemm_phase<pg8::EpiNull, pg8::StaticOrder, true, true>(F.lds + RING_OFF, g, S, EN); xcd_barrier(bar); }
            pg8::gemm_phase<pg8::EpiSwiGLU, pg8::StaticOrder, true, true>(F.lds + RING_OFF, g, S, E);
            if (TAILPREP && layer + 1 < DEPTH) tail_prep(F, layer + 1, (M / 256) * (NFF / 256), 1);
        }
        TSTAMP(tsl, 6);
        SEAM(pb + 4);
        TSTAMP(tsl, 7);
        }
        if (RUN(pb + 5)) {
            if (TAILPREP && layer + 1 < DEPTH) bias_reduce(F, layer + 1);
            pg8::Gemm g{F.act, wl + (size_t)n1 * D + (size_t)D * k2 + (size_t)NFF * D, M, D, DFF}; pg8::StaticOrder S; S.init(M, D, F.G, (int)blockIdx.x);
            pg8::EpiResid<false> E{nullptr, F.xb, F.xlo, F.ssq1};
            pg8::gemm_phase<pg8::EpiResid<false>, pg8::StaticOrder, false, true>(F.lds + RING_OFF, g, S, E);
        }
        TSTAMP(tsl, 14);
        SEAM(pb + 5);
        TSTAMP(tsl, 15);
    }
    if (RUN(NPHASES - 1)) final_norm(F);
    if (PROBE_A >= 0 && blockIdx.x == 0 && threadIdx.x == 0) {
        asm volatile("s_waitcnt vmcnt(0)" ::: "memory"); const unsigned long long dt = ts[PROBE_B] - ts[PROBE_A], t_end = __builtin_amdgcn_s_memrealtime() + 20ull * dt;
        while (__builtin_amdgcn_s_memrealtime() < t_end) __builtin_amdgcn_s_sleep(8); }
#undef RUN
#undef SEAM
}

extern "C" void kernel_launch(void* const* d_in, const int* in_sizes, int n_in, void* d_out, int out_size, void* d_ws, size_t ws_size, hipStream_t stream) {
    static int grid = 0;
    if (grid == 0) {
        if (n_in != 14 || in_sizes[0] != M * D || out_size != M * D || ws_size < WS_END) { fprintf(stderr, "kernel_launch: unexpected shapes / workspace (n_in %d, in0 %d, out %d, ws %zu)\n", n_in, n_in > 0 ? in_sizes[0] : -1, out_size, ws_size); grid = -1; return; }
        int dev = 0, cus = 0, per_cu = 0;
        if (hipGetDevice(&dev) != hipSuccess || hipDeviceGetAttribute(&cus, hipDeviceAttributeMultiprocessorCount, dev) != hipSuccess) { grid = -1; return; }
        if (hipFuncSetAttribute((const void*)fwd_kernel, hipFuncAttributeMaxDynamicSharedMemorySize, LDS_BYTES) != hipSuccess) { fprintf(stderr, "kernel_launch: hipFuncSetAttribute failed\n"); grid = -1; return; }
        if (hipOccupancyMaxActiveBlocksPerMultiprocessor(&per_cu, (const void*)fwd_kernel, NWAVES * 64, LDS_BYTES) != hipSuccess || per_cu < 1) fprintf(stderr, "kernel_launch: occupancy query reports %d blocks per CU\n", per_cu);
        (void)hipGetLastError();
        grid = cus;
        if (grid != 256) fprintf(stderr, "kernel_launch: %d CUs (built for 256)\n", grid);
    }
    if (grid < 0) return;
    (void)hipMemsetAsync((char*)d_ws + WS_CTL, 0, CTL_ZERO_BYTES, stream);
    Args a{};
    for (int i = 0; i < 14; ++i) a.in[i] = (const float*)d_in[i];
    a.out = (float*)d_out; a.ws = (unsigned char*)d_ws;
#if MK_MULTI
    for (int p = 0; p < NPHASES; ++p) {
        if (p >= 3 && p < NPHASES - 1 && ((p - 3) % 6) == 2 && (((p - 3) / 6) & 1) == 0) continue;
        a.ph_lo = p; a.ph_hi = p + 1;
        hipLaunchKernelGGL(fwd_kernel, dim3(grid), dim3(NWAVES * 64), LDS_BYTES, stream, a);
    }
#else
    a.ph_lo = 0; a.ph_hi = NPHASES;
    hipLaunchKernelGGL(fwd_kernel, dim3(grid), dim3(NWAVES * 64), LDS_BYTES, stream, a);
#endif
}
```
